# Optimizing an MI355X kernel written in HIP

```python
import jax, jax.numpy as jnp
from jax import lax
import numpy as np

D_MODEL = 1024
BATCH = 2
SEQ = 16384
DEPTH = 4

N_A_LAYERS = DEPTH // 2
N_B_LAYERS = DEPTH - N_A_LAYERS
D_RNN = D_MODEL
LRU_BLOCKS = 4
LRU_BLOCK_W = D_RNN // LRU_BLOCKS
CONV_W = 4
LRU_C = 8.0
N_HEADS = 8
HEAD_DIM = D_MODEL // N_HEADS
ROT_DIM = HEAD_DIM // 4
ROPE_THETA = 500000.0
MOBA_BLOCK = 256
MOBA_TOPK = 3
Q_CHUNK = 64
N_EXPERTS = 64
N_GROUPS = 8
TOPK_GROUPS = 4
TOPK_EXPERTS = 8
D_EXPERT = 256
D_SHARED = 256
ROUTED_SCALE = 2.5
MOE_ROW_BLOCK = 256
PLE_DIM = 256
DN_ALPHA = (2 * DEPTH) ** 0.25
DN_BETA = (8 * DEPTH) ** -0.25
LN_EPS = 1e-5

kernel_name = 'yoco_rglru_moba_moe_deepnorm'


def layer_norm(x, g, b):
    xf = x.astype(jnp.float32)
    mu = xf.mean(-1, keepdims=True)
    var = jnp.square(xf - mu).mean(-1, keepdims=True)
    y = (xf - mu) * lax.rsqrt(var + LN_EPS) * g.astype(jnp.float32) + b.astype(jnp.float32)
    return y.astype(x.dtype)


def rope_tables(seq, dtype):
    inv = ROPE_THETA ** (-jnp.arange(0, ROT_DIM, 2, dtype=jnp.float32) / ROT_DIM)
    ang = jnp.arange(seq, dtype=jnp.float32)[:, None] * inv[None, :]
    return jnp.cos(ang).astype(dtype), jnp.sin(ang).astype(dtype)


def apply_partial_rope(t, cos, sin):
    c = cos[None, :, None, :]
    s = sin[None, :, None, :]
    half = ROT_DIM // 2
    x1 = t[..., :half]
    x2 = t[..., half:ROT_DIM]
    return jnp.concatenate([x1 * c - x2 * s, x2 * c + x1 * s, t[..., ROT_DIM:]], axis=-1)


def _lin_combine(c1, c2):
    a1, b1 = c1
    a2, b2 = c2
    return a1 * a2, a2 * b1 + b2


def rglru_block(x, w_in, b_in, conv_w, conv_b, ga_w, ga_b, gi_w, gi_b, lam, w_out):
    B, S, _ = x.shape
    xy = x @ w_in + b_in
    xb, yb = jnp.split(xy, 2, axis=-1)
    y = jax.nn.gelu(yb, approximate=True)
    xp = jnp.pad(xb, ((0, 0), (CONV_W - 1, 0), (0, 0)))
    xc = conv_b + sum(xp[:, k:k + S] * conv_w[k] for k in range(CONV_W))
    xg = xc.reshape(B, S, LRU_BLOCKS, LRU_BLOCK_W)
    r = jax.nn.sigmoid(jnp.einsum('bsnc,ncd->bsnd', xg, ga_w) + ga_b).reshape(B, S, D_RNN)
    i = jax.nn.sigmoid(jnp.einsum('bsnc,ncd->bsnd', xg, gi_w) + gi_b).reshape(B, S, D_RNN)
    log_a = (-LRU_C * r.astype(jnp.float32)) * jax.nn.softplus(-lam.astype(jnp.float32))
    a = jnp.exp(log_a)
    u = jnp.sqrt(-jnp.expm1(2.0 * log_a)) * (i * xc).astype(jnp.float32)
    _, h = lax.associative_scan(_lin_combine, (a, u), axis=1)
    return (h.astype(x.dtype) * y) @ w_out


def shared_kv(xs, g, b, w_kv, cos, sin):
    B, S, _ = xs.shape
    h = layer_norm(xs, g, b)
    kv = (h @ w_kv).reshape(B, S, 2, N_HEADS, HEAD_DIM)
    k = apply_partial_rope(kv[:, :, 0], cos, sin).transpose(0, 2, 1, 3)
    v = kv[:, :, 1].transpose(0, 2, 1, 3)
    nb = -(-S // MOBA_BLOCK)
    pad = nb * MOBA_BLOCK - S
    k_blk = jnp.pad(k, ((0, 0), (0, 0), (0, pad), (0, 0))).reshape(B, N_HEADS, nb, MOBA_BLOCK, HEAD_DIM)
    v_blk = jnp.pad(v, ((0, 0), (0, 0), (0, pad), (0, 0))).reshape(B, N_HEADS, nb, MOBA_BLOCK, HEAD_DIM)
    k_mean = k_blk.astype(jnp.float32).mean(axis=3)
    return k_blk, v_blk, k_mean


def moba_attention(x, w_q, w_o, k_blk, v_blk, k_mean, cos, sin):
    B, S, _ = x.shape
    nb = k_blk.shape[2]
    tk = min(MOBA_TOPK, nb)
    q = apply_partial_rope((x @ w_q).reshape(B, S, N_HEADS, HEAD_DIM), cos, sin) * (HEAD_DIM ** -0.5)
    q = q.transpose(0, 2, 1, 3)
    bi = jnp.arange(B)[:, None, None, None]
    hi = jnp.arange(N_HEADS)[None, :, None, None]
    blk_ids = jnp.arange(nb)

    def chunk(c):
        q0 = c * Q_CHUNK
        qc = lax.dynamic_slice_in_dim(q, q0, Q_CHUNK, axis=2)
        own = q0 // MOBA_BLOCK
        gate = jnp.einsum('bhqd,bhnd->bhqn', qc.astype(jnp.float32), k_mean)
        gate = jnp.where(blk_ids < own, gate, -jnp.inf)
        _, sel = lax.top_k(gate, tk)
        valid = sel < own
        k_sel = k_blk[bi, hi, sel]
        v_sel = v_blk[bi, hi, sel]
        s_sel = jnp.einsum('bhqd,bhqjkd->bhqjk', qc, k_sel, preferred_element_type=jnp.float32)
        s_sel = jnp.where(valid[..., None], s_sel, -jnp.inf).reshape(B, N_HEADS, Q_CHUNK, tk * MOBA_BLOCK)
        k_own = lax.dynamic_index_in_dim(k_blk, own, axis=2, keepdims=False)
        v_own = lax.dynamic_index_in_dim(v_blk, own, axis=2, keepdims=False)
        s_own = jnp.einsum('bhqd,bhkd->bhqk', qc, k_own, preferred_element_type=jnp.float32)
        qpos = q0 + jnp.arange(Q_CHUNK)
        kpos = own * MOBA_BLOCK + jnp.arange(MOBA_BLOCK)
        s_own = jnp.where(kpos[None, :] <= qpos[:, None], s_own, -jnp.inf)
        probs = jax.nn.softmax(jnp.concatenate([s_sel, s_own], axis=-1), axis=-1).astype(v_blk.dtype)
        p_sel = probs[..., :tk * MOBA_BLOCK].reshape(B, N_HEADS, Q_CHUNK, tk, MOBA_BLOCK)
        p_own = probs[..., tk * MOBA_BLOCK:]
        return (jnp.einsum('bhqjk,bhqjkd->bhqd', p_sel, v_sel)
                + jnp.einsum('bhqk,bhkd->bhqd', p_own, v_own))

    out = lax.map(chunk, jnp.arange(S // Q_CHUNK))
    out = out.transpose(1, 0, 3, 2, 4).reshape(B, S, N_HEADS * HEAD_DIM)
    return out @ w_o


def moe_ffn(x, router_w, router_b, w_gate, w_up, w_down, s_gate, s_up, s_down):
    B, S, D = x.shape
    N = B * S
    M = MOE_ROW_BLOCK
    xt = x.reshape(N, D)
    scores = jax.nn.sigmoid(jnp.einsum('nd,de->ne', xt, router_w, preferred_element_type=jnp.float32))
    choice = scores + router_b.astype(jnp.float32)
    grp = choice.reshape(N, N_GROUPS, N_EXPERTS // N_GROUPS)
    grp_score = lax.top_k(grp, 2)[0].sum(-1)
    _, grp_idx = lax.top_k(grp_score, TOPK_GROUPS)
    grp_mask = jax.nn.one_hot(grp_idx, N_GROUPS, dtype=jnp.float32).sum(1) > 0
    expert_mask = jnp.repeat(grp_mask, N_EXPERTS // N_GROUPS, axis=1)
    choice = jnp.where(expert_mask, choice, -jnp.inf)
    _, e_idx = lax.top_k(choice, TOPK_EXPERTS)
    w = jnp.take_along_axis(scores, e_idx, axis=1)
    w = w / w.sum(-1, keepdims=True) * ROUTED_SCALE
    NK = N * TOPK_EXPERTS
    flat_e = e_idx.reshape(NK)
    flat_tok = jnp.repeat(jnp.arange(N, dtype=jnp.int32), TOPK_EXPERTS)
    flat_w = w.reshape(NK)
    order = jnp.argsort(flat_e)
    se, stok, sw = flat_e[order], flat_tok[order], flat_w[order]
    counts = jnp.bincount(flat_e, length=N_EXPERTS)
    starts = jnp.cumsum(counts) - counts
    padded = (counts + M - 1) // M * M
    pends = jnp.cumsum(padded)
    pstarts = pends - padded
    pos = pstarts[se] + jnp.arange(NK) - starts[se]
    n_blocks = -(-NK // M) + N_EXPERTS
    R = n_blocks * M
    buf_tok = jnp.zeros((R,), jnp.int32).at[pos].set(stok)
    buf_w = jnp.zeros((R,), jnp.float32).at[pos].set(sw)
    blk_e = jnp.minimum(jnp.searchsorted(pends, jnp.arange(n_blocks) * M, side='right'), N_EXPERTS - 1)

    def step(acc, blk):
        tok, wt, e = blk
        xs = xt[tok]
        hdn = jax.nn.silu(xs @ w_gate[e]) * (xs @ w_up[e])
        y = (hdn @ w_down[e]).astype(jnp.float32) * wt[:, None]
        return acc.at[tok].add(y), None

    acc, _ = lax.scan(step, jnp.zeros((N, D), jnp.float32),
                      (buf_tok.reshape(n_blocks, M), buf_w.reshape(n_blocks, M), blk_e))
    shared = (jax.nn.silu(xt @ s_gate) * (xt @ s_up)) @ s_down
    return (acc.astype(x.dtype) + shared).reshape(B, S, D)


def setup_inputs(seed: int = 0) -> dict:
    key = jax.random.key(seed)
    ks = iter(jax.random.split(key, 32))
    f32 = jnp.float32

    def nrm(shape, scale):
        return jax.random.normal(next(ks), shape, f32) * scale

    x = nrm((BATCH, SEQ, D_MODEL), 1.0)
    p = nrm((DEPTH, BATCH, SEQ, PLE_DIM), 1.0)
    ln_g = 1.0 + nrm((DEPTH, 2, D_MODEL), 0.02)
    ln_b = nrm((DEPTH, 2, D_MODEL), 0.02)
    a_w_in = nrm((N_A_LAYERS, D_MODEL, 2 * D_RNN), D_MODEL ** -0.5)
    a_b_in = nrm((N_A_LAYERS, 2 * D_RNN), 0.01)
    a_conv_w = nrm((N_A_LAYERS, CONV_W, D_RNN), CONV_W ** -0.5)
    a_conv_b = nrm((N_A_LAYERS, D_RNN), 0.01)
    a_gate_a_w = nrm((N_A_LAYERS, LRU_BLOCKS, LRU_BLOCK_W, LRU_BLOCK_W), LRU_BLOCK_W ** -0.5)
    a_gate_a_b = nrm((N_A_LAYERS, LRU_BLOCKS, LRU_BLOCK_W), 0.01)
    a_gate_i_w = nrm((N_A_LAYERS, LRU_BLOCKS, LRU_BLOCK_W, LRU_BLOCK_W), LRU_BLOCK_W ** -0.5)
    a_gate_i_b = nrm((N_A_LAYERS, LRU_BLOCKS, LRU_BLOCK_W), 0.01)
    u = jax.random.uniform(next(ks), (N_A_LAYERS, D_RNN), f32, minval=0.9, maxval=0.999)
    s = u ** (1.0 / LRU_C)
    a_lambda = jnp.log(s) - jnp.log1p(-s)
    a_w_out = nrm((N_A_LAYERS, D_RNN, D_MODEL), D_RNN ** -0.5 * DN_BETA)
    kv_ln_g = 1.0 + nrm((D_MODEL,), 0.02)
    kv_ln_b = nrm((D_MODEL,), 0.02)
    w_kv = nrm((D_MODEL, 2 * N_HEADS * HEAD_DIM), D_MODEL ** -0.5)
    b_w_q = nrm((N_B_LAYERS, D_MODEL, N_HEADS * HEAD_DIM), D_MODEL ** -0.5)
    b_w_o = nrm((N_B_LAYERS, N_HEADS * HEAD_DIM, D_MODEL), (N_HEADS * HEAD_DIM) ** -0.5 * DN_BETA)
    router_w = nrm((DEPTH, D_MODEL, N_EXPERTS), D_MODEL ** -0.5)
    router_b = nrm((DEPTH, N_EXPERTS), 0.01)
    exp_w_gate = nrm((DEPTH, N_EXPERTS, D_MODEL, D_EXPERT), D_MODEL ** -0.5)
    exp_w_up = nrm((DEPTH, N_EXPERTS, D_MODEL, D_EXPERT), D_MODEL ** -0.5)
    exp_w_down = nrm((DEPTH, N_EXPERTS, D_EXPERT, D_MODEL), D_EXPERT ** -0.5 * DN_BETA)
    sh_w_gate = nrm((DEPTH, D_MODEL, D_SHARED), D_MODEL ** -0.5)
    sh_w_up = nrm((DEPTH, D_MODEL, D_SHARED), D_MODEL ** -0.5)
    sh_w_down = nrm((DEPTH, D_SHARED, D_MODEL), D_SHARED ** -0.5 * DN_BETA)
    ple_w = nrm((DEPTH, PLE_DIM, D_MODEL), PLE_DIM ** -0.5)
    ple_gate_w = nrm((DEPTH, D_MODEL, D_MODEL), D_MODEL ** -0.5)
    return {'x': x, 'p': p, 'ln_g': ln_g, 'ln_b': ln_b,
            'a_w_in': a_w_in, 'a_b_in': a_b_in, 'a_conv_w': a_conv_w, 'a_conv_b': a_conv_b,
            'a_gate_a_w': a_gate_a_w, 'a_gate_a_b': a_gate_a_b, 'a_gate_i_w': a_gate_i_w,
            'a_gate_i_b': a_gate_i_b, 'a_lambda': a_lambda, 'a_w_out': a_w_out,
            'kv_ln_g': kv_ln_g, 'kv_ln_b': kv_ln_b, 'w_kv': w_kv, 'b_w_q': b_w_q, 'b_w_o': b_w_o,
            'router_w': router_w, 'router_b': router_b, 'exp_w_gate': exp_w_gate,
            'exp_w_up': exp_w_up, 'exp_w_down': exp_w_down, 'sh_w_gate': sh_w_gate,
            'sh_w_up': sh_w_up, 'sh_w_down': sh_w_down, 'ple_w': ple_w, 'ple_gate_w': ple_gate_w}


def reference(x, p, ln_g, ln_b, a_w_in, a_b_in, a_conv_w, a_conv_b, a_gate_a_w, a_gate_a_b,
              a_gate_i_w, a_gate_i_b, a_lambda, a_w_out, kv_ln_g, kv_ln_b, w_kv, b_w_q, b_w_o,
              router_w, router_b, exp_w_gate, exp_w_up, exp_w_down, sh_w_gate, sh_w_up,
              sh_w_down, ple_w, ple_gate_w):
    S = x.shape[1]
    cos, sin = rope_tables(S, x.dtype)
    for i in range(DEPTH):
        if i < N_A_LAYERS:
            mix = rglru_block(x, a_w_in[i], a_b_in[i], a_conv_w[i], a_conv_b[i], a_gate_a_w[i],
                              a_gate_a_b[i], a_gate_i_w[i], a_gate_i_b[i], a_lambda[i], a_w_out[i])
        else:
            if i == N_A_LAYERS:
                k_blk, v_blk, k_mean = shared_kv(x, kv_ln_g, kv_ln_b, w_kv, cos, sin)
            j = i - N_A_LAYERS
            mix = moba_attention(x, b_w_q[j], b_w_o[j], k_blk, v_blk, k_mean, cos, sin)
        x = layer_norm(DN_ALPHA * x + mix, ln_g[i, 0], ln_b[i, 0])
        ffn = moe_ffn(x, router_w[i], router_b[i], exp_w_gate[i], exp_w_up[i], exp_w_down[i],
                      sh_w_gate[i], sh_w_up[i], sh_w_down[i])
        x = layer_norm(DN_ALPHA * x + ffn, ln_g[i, 1], ln_b[i, 1])
        x = x + (p[i] @ ple_w[i]) * jax.nn.sigmoid(x @ ple_gate_w[i])
    return x
```

```cpp
#include <hip/hip_runtime.h>
#include <cstdio>
#include <cstdint>
#include <cmath>

#ifndef MK_MULTI
#define MK_MULTI 0
#endif
#ifndef EN_RGLRU
#define EN_RGLRU 1
#endif
#ifndef EN_MOBA
#define EN_MOBA 1
#endif

#define LAS __attribute__((address_space(3)))
typedef unsigned short bf16_t;
typedef short bf16x8 __attribute__((ext_vector_type(8)));
typedef short s16x4 __attribute__((ext_vector_type(4)));
typedef float f32x4 __attribute__((ext_vector_type(4)));
typedef float f32x2 __attribute__((ext_vector_type(2)));
typedef float f32x16 __attribute__((ext_vector_type(16)));
typedef unsigned u32x4 __attribute__((ext_vector_type(4)));
typedef unsigned u32x2 __attribute__((ext_vector_type(2)));
typedef int i32x4 __attribute__((ext_vector_type(4)));

constexpr int NTOK = 32768, DM = 1024, SEQ = 16384, NBATCH = 2, DEPTH = 4;
constexpr int NEXP = 64, DEXP = 256, PLE = 256, NHEAD = 8, HD = 128, MBLK = 256, NBLK = 64;
constexpr float DN_ALPHA = 1.6817928305074290f;
constexpr float LN_EPS = 1e-5f;
constexpr int NWAVES = 8, NTHR = 512;

constexpr size_t MiB = (size_t)1 << 20;
constexpr size_t WS_CTL = 0, CTL_BYTES = 2 * MiB;
constexpr size_t WS_KM = 1 * MiB;
constexpr size_t WS_ROPE = 2 * MiB;
constexpr size_t WS_WL = 4 * MiB;
constexpr size_t WL_MIX = 0;
constexpr size_t WL_ROUTER = 8 * MiB, WL_SHGU = 8 * MiB + 512 * 1024, WL_SHD = 9 * MiB + 512 * 1024, WL_PLEG = 10 * MiB, WL_PLEW = 12 * MiB;
constexpr size_t WL_EGU = 13 * MiB, WL_ED = 77 * MiB;
constexpr size_t WS_WL2 = 132 * MiB;
constexpr size_t WS_PB = 116 * MiB;
constexpr size_t WS_XS = 132 * MiB;
constexpr size_t WS_SB0 = 260 * MiB, WS_SB1 = 324 * MiB;
constexpr size_t WS_KB = 388 * MiB, WS_VB = 452 * MiB;
constexpr size_t WS_PW = 516 * MiB;
constexpr size_t WS_TMP = 580 * MiB;
constexpr size_t WS_HDN = WS_TMP;
constexpr size_t WS_HSH = 757 * MiB;
constexpr size_t WS_YSH = 725 * MiB;
constexpr size_t WS_YP = 773 * MiB;
constexpr size_t WS_ELIST = 1045 * MiB;
constexpr size_t WS_WPAIR = 1053 * MiB;
constexpr size_t WS_PPOS = 1055 * MiB;
constexpr size_t WS_IDL = 1054 * MiB;
constexpr size_t WS_END = 1056 * MiB;
constexpr size_t WS_XBR = WS_TMP, WS_Y = WS_TMP + 64 * MiB, WS_XC = WS_TMP + 128 * MiB, WS_LA = WS_TMP + 192 * MiB, WS_U = WS_TMP + 256 * MiB, WS_HY = WS_TMP + 320 * MiB;
constexpr size_t WS_CH = WS_TMP + 384 * MiB;
constexpr size_t WS_Q = WS_TMP, WS_ATT = WS_TMP + 64 * MiB, WS_PART = WS_TMP + 128 * MiB  , WS_ML = WS_TMP + 384 * MiB  , WS_ALIST = WS_TMP + 392 * MiB  ;
constexpr int CW_BAR = 4096, CW_ECNT = 8192  , CW_ACNT = 9216  , CW_AQ = 11264  ;

constexpr int LDS_BYTES = 147456;
constexpr int MISC_OFF = 139264;
constexpr int MS_BAR = 0, MS_TAB = 64;

__device__ __forceinline__ unsigned cvt_pk_bf16(float lo, float hi) { unsigned r; asm volatile("v_cvt_pk_bf16_f32 %0, %1, %2" : "=v"(r) : "v"(lo), "v"(hi)); return r; }
__device__ __forceinline__ float bf2f(unsigned short b) { return __uint_as_float(((unsigned)b) << 16); }
__device__ __forceinline__ float bflo(unsigned w) { return __uint_as_float(w << 16); }
__device__ __forceinline__ float bfhi(unsigned w) { return __uint_as_float(w & 0xffff0000u); }
__device__ __forceinline__ float sigmoidf_(float x) { return __builtin_amdgcn_rcpf(1.0f + __expf(-x)); }
__device__ __forceinline__ float dpp_add(float v, int ctrl_is_unused);
#define DPP_ADD(v, CTRL) ((v) + __int_as_float(__builtin_amdgcn_update_dpp(0, __float_as_int(v), (CTRL), 0xF, 0xF, true)))
__device__ __forceinline__ float row_sum16(float v) { v = DPP_ADD(v, 0xB1); v = DPP_ADD(v, 0x4E); v = DPP_ADD(v, 0x141); v = DPP_ADD(v, 0x140); return v; }
__device__ __forceinline__ float wave_sum(float v) {
    v = row_sum16(v);
    const int iv = __float_as_int(v);
    return (__int_as_float(__builtin_amdgcn_readlane(iv, 0)) + __int_as_float(__builtin_amdgcn_readlane(iv, 16))) + (__int_as_float(__builtin_amdgcn_readlane(iv, 32)) + __int_as_float(__builtin_amdgcn_readlane(iv, 48)));
}
__device__ __forceinline__ void wave_sum2(float& a, float& b) { a = wave_sum(a); b = wave_sum(b); }
__device__ __forceinline__ int lane_id() { int l; asm volatile("v_mbcnt_lo_u32_b32 %0, -1, 0\n\tv_mbcnt_hi_u32_b32 %0, -1, %0" : "=v"(l)); return l; }
#define LDS_WAIT() asm volatile("s_waitcnt lgkmcnt(0)" ::: "memory")
#define VM_WAIT() asm volatile("s_waitcnt vmcnt(0)" ::: "memory")

#define XB_TMO      128
#define XB_XCNT(j)  (256  + 64 * (j))
#define XB_XSUB(j)  (1280 + 64 * (j))
#define XB_XGEN(j)  (2304 + 64 * (j))
#define XB_TOP      3328
#define XB_TOPGEN   3392
#define XCD_BAR_WORDS 3456
#define XB_SPIN_CAP (1u << 18)
__device__ __forceinline__ unsigned xb_ld(unsigned* p)              { return __hip_atomic_load(p, __ATOMIC_RELAXED, __HIP_MEMORY_SCOPE_AGENT); }
__device__ __forceinline__ unsigned xb_add(unsigned* p, unsigned v) { return __hip_atomic_fetch_add(p, v, __ATOMIC_RELAXED, __HIP_MEMORY_SCOPE_AGENT); }
__device__ __forceinline__ unsigned xb_xcc_id() { return (unsigned)__builtin_amdgcn_s_getreg((3 << 11) | 20) & 0xFu; }
#define XB_SPIN(cond, bar) do { unsigned _sp = 0; while (cond) { __builtin_amdgcn_s_sleep(1); \
    if ((++_sp & 255u) == 0u) { if (xb_ld(&(bar)[XB_TMO])) break; if (_sp > XB_SPIN_CAP) { atomicAdd(&(bar)[XB_TMO], 1u); break; } } } } while (0)
struct XcdBarrier { unsigned* bar; unsigned x; volatile LAS unsigned* st; };
__device__ __forceinline__ XcdBarrier xcd_barrier_post(unsigned* bar, volatile LAS unsigned* st) {
    XcdBarrier b; b.bar = bar; b.x = xb_xcc_id(); b.st = st;
    if (threadIdx.x == 0) (void)xb_add(&bar[XB_XCNT(b.x)], 1u);
    return b;
}
__device__ __forceinline__ void xcd_barrier_complete(unsigned* bar, unsigned x, unsigned& nloc, unsigned& nx) {
    const unsigned G = gridDim.x * gridDim.y * gridDim.z;
    unsigned sum, cnt, mine, sp = 0u;
    for (;;) {
        sum = 0u; cnt = 0u; mine = 0u;
#pragma unroll
        for (unsigned j = 0; j < 16; ++j) { const unsigned c = xb_ld(&bar[XB_XCNT(j)]); sum += c; cnt += (c > 0u) ? 1u : 0u; mine = (j == x) ? c : mine; }
        if (sum == G) break;
        __builtin_amdgcn_s_sleep(1);
        if ((++sp & 255u) == 0u) { if (xb_ld(&bar[XB_TMO])) break; if (sp > XB_SPIN_CAP) { atomicAdd(&bar[XB_TMO], 1u); break; } }
    }
    nloc = mine > 0u ? mine : 1u; nx = cnt > 0u ? cnt : 1u;
}
__device__ __forceinline__ void xcd_barrier(const XcdBarrier& b, bool leader) {
    asm volatile("s_waitcnt vmcnt(0)" ::: "memory");
    __syncthreads();
    if (leader) {
        unsigned* bar = b.bar;
        __builtin_amdgcn_s_waitcnt(0);
        unsigned nloc = b.st[0], nx = b.st[1];
        if (nloc == 0u) { xcd_barrier_complete(bar, b.x, nloc, nx); b.st[0] = nloc; b.st[1] = nx; }
        const unsigned old = xb_add(&bar[XB_XSUB(b.x)], 1u);
        const unsigned gen = old / nloc;
        if (old + 1u == (gen + 1u) * nloc) {
            __builtin_amdgcn_fence(__ATOMIC_RELEASE, "agent");
            asm volatile("s_waitcnt vmcnt(0)" ::: "memory");
            const unsigned og = xb_add(&bar[XB_TOP], 1u);
            const unsigned tg = og / nx;
            if (og + 1u == (tg + 1u) * nx) xb_add(&bar[XB_TOPGEN], 1u);
            else XB_SPIN(xb_ld(&bar[XB_TOPGEN]) == tg, bar);
            __builtin_amdgcn_fence(__ATOMIC_ACQUIRE, "agent");
            xb_add(&bar[XB_XGEN(b.x)], 1u);
            asm volatile("s_waitcnt vmcnt(0)" ::: "memory");
        } else {
            XB_SPIN(xb_ld(&bar[XB_XGEN(b.x)]) == gen, bar);
            __builtin_amdgcn_fence(__ATOMIC_ACQUIRE, "agent");
            asm volatile("s_waitcnt vmcnt(0)" ::: "memory");
        }
    }
    __syncthreads();
}

namespace ge {
constexpr int BM = 256, BK = 64, HALF = 128, HTB = HALF * BK * 2, STAGE_BYTES = 8 * HTB;
__device__ __forceinline__ int lds_byte(int r, int c) { const int st = (r >> 4) * 2 + (c >> 5), rr = r & 15, cc = c & 31, ob = rr * 64 + cc * 2; return st * 1024 + (ob ^ (((ob >> 9) & 1) << 5)); }
__device__ __forceinline__ void stage_rc(int b, int& R, int& C) { const int st = b / 1024, sb = b % 1024, swz = sb ^ (((sb >> 9) & 1) << 5); R = (st >> 1) * 16 + swz / 64; C = (st & 1) * 32 + (swz % 64) / 2; }
__device__ __forceinline__ int perm32(int rho) { const int n = rho >> 4, i = rho & 15; return 8 * (i >> 2) + 4 * n + (i & 3); }

__device__ __forceinline__ void glds16(const void* sbase, unsigned voff, unsigned lds_dst) {
    unsigned keep;
    asm volatile("s_mov_b32 %0, m0\n\ts_mov_b32 m0, %3\n\ts_nop 0\n\tglobal_load_lds_dwordx4 %1, %2\n\ts_mov_b32 m0, %0" : "=&s"(keep) : "v"(voff), "s"(sbase), "s"(lds_dst) : "memory");
}
__device__ __forceinline__ const void* uniform_ptr(const void* p) { const unsigned long long v = (unsigned long long)(uintptr_t)p;
    const unsigned lo = __builtin_amdgcn_readfirstlane((unsigned)v), hi = __builtin_amdgcn_readfirstlane((unsigned)(v >> 32)); return (const void*)(uintptr_t)(((unsigned long long)hi << 32) | lo); }
__device__ __forceinline__ void glds4(const void* sbase, unsigned voff, unsigned lds_dst) {
    unsigned keep;
    asm volatile("s_mov_b32 %0, m0\n\ts_mov_b32 m0, %3\n\ts_nop 3\n\tglobal_load_lds_dword %1, %2\n\ts_mov_b32 m0, %0" : "=&s"(keep) : "v"(voff), "s"(sbase), "s"(lds_dst) : "memory");
}
constexpr int TAB_OFF = 139264 + 2048;
struct Unit {
    size_t a_off;
    const int* rows;
    int row0, nrows;
    const bf16_t* B;
    int pm, pn;
    int x0, x1;
};
__device__ __forceinline__ void static_tile(long L, int nM, int nN, int& pm, int& pn) {
    const int nwg = nM * nN; int wgid = (int)L;
    { const int q = nwg / 8, r = nwg % 8, xcd = wgid % 8, off = wgid / 8; wgid = (xcd < r ? xcd * (q + 1) : r * (q + 1) + (xcd - r) * q) + off; }
    const int nig = 8 * nN, gid = wgid / nig, fm = gid * 8, gsz = (nM - fm) < 8 ? (nM - fm) : 8;
    pm = fm + ((wgid % nig) % gsz); pn = (wgid % nig) / gsz;
}
template <int RSH> __device__ __forceinline__ unsigned arow(const Unit& u, int r) {
    return (unsigned)(u.rows[r < u.nrows ? r : 0] >> RSH);
}

template <int K, int LDA, int LDB, int RSH, int PERM, bool GATHER, bool AIL = false, bool SP2V = false, class Sched, class Epi>
__device__ __forceinline__ void gemm_phase(LAS unsigned char* lds, int tid, const bf16_t* Abase, const Sched& S, const Epi& E) {
    asm volatile("" : "+v"(tid));
    const int wid = __builtin_amdgcn_readfirstlane(tid >> 6), lane = tid & 63, wr = wid >> 2, wc = wid & 3, fr = lane & 15, fq = lane >> 4;
    constexpr int nt = K / BK;
    static_assert(K % 128 == 0, "K multiple of 128");
    int R0, C0, R1, C1; stage_rc(tid * 16, R0, C0); stage_rc(tid * 16 + 8192, R1, C1);
    const int Rb0 = PERM == 1 ? ((R0 & ~31) + perm32(R0 & 31)) : PERM == 2 ? (64 * (R0 >> 5) + 16 * ((R0 >> 2) & 3) + 4 * ((R0 >> 4) & 1) + (R0 & 3)) : PERM == 3 ? (64 * (R0 >> 5) + perm32(R0 & 31)) : PERM == 4 ? (64 * (R0 >> 5) + (R0 & 31)) : R0;
    const int Rb1 = PERM == 1 ? ((R1 & ~31) + perm32(R1 & 31)) : PERM == 2 ? (64 * (R1 >> 5) + 16 * ((R1 >> 2) & 3) + 4 * ((R1 >> 4) & 1) + (R1 & 3)) : PERM == 3 ? (64 * (R1 >> 5) + perm32(R1 & 31)) : PERM == 4 ? (64 * (R1 >> 5) + (R1 & 31)) : R1;
    const unsigned vB0 = (unsigned)(Rb0 * LDB + C0) * 2u, vB1 = (unsigned)(Rb1 * LDB + C1) * 2u;
    const unsigned cA0 = (unsigned)C0 * 2u, cA1 = (unsigned)C1 * 2u;
    constexpr size_t kstep = (size_t)BK * 2, kstepA = AIL ? (size_t)BK * 4 : (size_t)BK * 2;
    static_assert(!(AIL && GATHER), "AIL needs identity rows");
    constexpr size_t hstepB = PERM == 2 ? (size_t)8 * LDB * 2 : (PERM == 3 || PERM == 4) ? (size_t)32 * LDB * 2 : (size_t)HALF * LDB * 2;
    constexpr size_t hstepA = GATHER ? 0 : (size_t)HALF * LDA * 2;
    const unsigned vA0 = AIL ? (unsigned)((R0 >> 1) * 2 * LDA + (C0 >> 5) * 64 + (R0 & 1) * 32 + (C0 & 31)) * 2u : (unsigned)(R0 * LDA + C0) * 2u;
    const unsigned vA1 = AIL ? (unsigned)((R1 >> 1) * 2 * LDA + (C1 >> 5) * 64 + (R1 & 1) * 32 + (C1 & 31)) * 2u : (unsigned)(R1 * LDA + C1) * 2u;
    const unsigned ldsw = (unsigned)wid * 1024u;
    const unsigned ldsbase = (unsigned)(uintptr_t)lds;
    const int aoff = lds_byte(wr * 64 + fr, fq * 8), boff = lds_byte(wc * 32 + fr, fq * 8);
#define GE_SA(b, h) (((b) * 2 + (h)) * HTB)
#define GE_SB(b, h) ((4 + (b) * 2 + (h)) * HTB)
#define GE_GLDS(sbase, voff, ldsoff) ge::glds16((const void*)(sbase), (voff), ldsbase + (unsigned)(ldsoff))
#define GE_STA(bufoff, gbase, o0, o1) do { GE_GLDS(gbase, o0, (bufoff) + ldsw); GE_GLDS(gbase, o1, (bufoff) + ldsw + 8192); } while (0)
#define GE_STB(bufoff, gbase) do { GE_GLDS(gbase, vB0, (bufoff) + ldsw); GE_GLDS(gbase, vB1, (bufoff) + ldsw + 8192); } while (0)
#define GE_LDA(dst, b, h) do { _Pragma("unroll") for (int m = 0; m < 4; ++m) _Pragma("unroll") for (int k = 0; k < 2; ++k) dst[m][k] = *(const LAS bf16x8*)(lds + GE_SA(b, h) + aoff + m * 2048 + k * 1024); } while (0)
#define GE_LDB(dst, b, h) do { _Pragma("unroll") for (int n = 0; n < 2; ++n) _Pragma("unroll") for (int k = 0; k < 2; ++k) dst[n][k] = *(const LAS bf16x8*)(lds + GE_SB(b, h) + boff + n * 2048 + k * 1024); } while (0)
#define GE_MMA(ai, bj, At, Bt) do { __builtin_amdgcn_s_setprio(1); _Pragma("unroll") for (int m = 0; m < 4; ++m) _Pragma("unroll") for (int n = 0; n < 2; ++n) _Pragma("unroll") for (int k = 0; k < 2; ++k) \
        acc[ai][bj][m][n] = __builtin_amdgcn_mfma_f32_16x16x32_bf16(Bt[n][k], At[m][k], acc[ai][bj][m][n], 0, 0, 0); __builtin_amdgcn_s_setprio(0); } while (0)
#define GE_WAIT_V(n) asm volatile("s_waitcnt vmcnt(" #n ")" ::: "memory")
#define GE_WAIT_L(n) asm volatile("s_waitcnt lgkmcnt(" #n ")" ::: "memory")
#define GE_BAR __builtin_amdgcn_s_barrier()
#define GE_SCHED __builtin_amdgcn_sched_barrier(0)
    Unit cur, nxt; int ui = 0;
    if (!S.next(0, cur)) return;
    f32x4 acc[2][2][4][2];
#pragma unroll
    for (int a = 0; a < 2; ++a)
#pragma unroll
        for (int b = 0; b < 2; ++b)
#pragma unroll
            for (int m = 0; m < 4; ++m)
#pragma unroll
                for (int n = 0; n < 2; ++n) acc[a][b][m][n] = (f32x4){0.f, 0.f, 0.f, 0.f};
    bf16x8 At[4][2], B0[2][2], B1[2][2];
    unsigned oc00, oc01, oc10, oc11, on00, on01, on10, on11;
    if constexpr (GATHER) {
        oc00 = arow<RSH>(cur, R0) * (unsigned)(LDA * 2) + cA0; oc01 = arow<RSH>(cur, R1) * (unsigned)(LDA * 2) + cA1;
        oc10 = arow<RSH>(cur, HALF + R0) * (unsigned)(LDA * 2) + cA0; oc11 = arow<RSH>(cur, HALF + R1) * (unsigned)(LDA * 2) + cA1;
    } else { oc00 = vA0; oc01 = vA1; oc10 = vA0; oc11 = vA1; }
    const char* cA = (const char*)Abase + cur.a_off + (GATHER ? (size_t)0 : (size_t)cur.row0 * LDA * 2); const char* cB = (const char*)cur.B;
    const unsigned tabbase = (unsigned)(uintptr_t)lds - 0u + (unsigned)TAB_OFF;
    const int trow = wid * 64 + lane;
    if constexpr (Epi::HAS_IDX) { if (wid < 4) { const int rc = trow < cur.nrows ? trow : cur.nrows - 1; glds4(uniform_ptr(E.idx_base(cur)), (unsigned)(E.idx_off(cur) + rc) * 4u, (unsigned)__builtin_amdgcn_readfirstlane(tabbase + (unsigned)wid * 256u)); } }
    if constexpr (SP2V) {
        GE_STB(GE_SB(0, 0), cB); GE_STB(GE_SB(0, 1), cB + hstepB); GE_STA(GE_SA(0, 0), cA, oc00, oc01); GE_STA(GE_SA(0, 1), cA + hstepA, oc10, oc11);
        if (wr == 1) GE_BAR;
        GE_WAIT_V(2); GE_BAR;
    } else {
    GE_STB(GE_SB(0, 0), cB); GE_STA(GE_SA(0, 0), cA, oc00, oc01); GE_STB(GE_SB(0, 1), cB + hstepB); GE_STA(GE_SA(0, 1), cA + hstepA, oc10, oc11);
    if (wr == 1) GE_BAR;
    GE_WAIT_V(4); GE_BAR;
    }
    GE_STB(GE_SB(1, 0), cB + kstep); GE_STA(GE_SA(1, 0), cA + kstepA, oc00, oc01); GE_STB(GE_SB(1, 1), cB + hstepB + kstep);
    GE_WAIT_V(6); GE_BAR;
    for (;;) {
        const bool has_next = S.next(ui + 1, nxt);
        if (!has_next) nxt = cur;
        if constexpr (GATHER) {
            if (wid < 4) { const int rc = trow < nxt.nrows ? trow : nxt.nrows - 1; glds4(uniform_ptr(nxt.rows), (unsigned)rc * 4u, (unsigned)__builtin_amdgcn_readfirstlane(tabbase + (unsigned)(((ui + 1) & 1) * 1024 + wid * 256))); }
            on00 = oc00; on01 = oc01; on10 = oc10; on11 = oc11;
        } else { on00 = vA0; on01 = vA1; on10 = vA0; on11 = vA1; }
        const char* nA = (const char*)Abase + nxt.a_off + (GATHER ? (size_t)0 : (size_t)nxt.row0 * LDA * 2); const char* nB = (const char*)nxt.B;
#pragma unroll 1
        for (int t = 0; t < nt; t += 2) {
            const bool last = (t == nt - 2);
            const char* a1 = cA + (size_t)(t + 1) * kstepA;
            const char* a2 = last ? nA : cA + (size_t)(t + 2) * kstepA; const char* b2 = last ? nB : cB + (size_t)(t + 2) * kstep;
            const char* a3 = a2 + kstepA; const char* b3 = b2 + kstep;
            if constexpr (SP2V) {
            GE_LDB(B0, 0, 0); GE_LDB(B1, 0, 1); GE_SCHED; GE_LDA(At, 0, 0); GE_STA(GE_SA(1, 1), a1 + hstepA, oc10, oc11);
            if (!(t == 0 && ui > 0)) GE_WAIT_V(8);
            GE_WAIT_L(0); GE_BAR; GE_MMA(0, 0, At, B0); GE_MMA(0, 1, At, B1); GE_BAR; GE_SCHED;
            if constexpr (GATHER) { if (last) {
                const LAS int* tb = (const LAS int*)(lds + TAB_OFF + ((ui + 1) & 1) * 1024);
                oc00 = (unsigned)(tb[R0] >> RSH) * (unsigned)(LDA * 2) + cA0; oc01 = (unsigned)(tb[R1] >> RSH) * (unsigned)(LDA * 2) + cA1;
                oc10 = (unsigned)(tb[HALF + R0] >> RSH) * (unsigned)(LDA * 2) + cA0; oc11 = (unsigned)(tb[HALF + R1] >> RSH) * (unsigned)(LDA * 2) + cA1; } }
            GE_LDA(At, 0, 1); GE_STB(GE_SB(0, 0), b2); GE_STB(GE_SB(0, 1), b2 + hstepB); GE_STA(GE_SA(0, 0), a2, oc00, oc01);
            GE_WAIT_V(8); GE_WAIT_L(0); GE_BAR; GE_MMA(1, 0, At, B0); GE_MMA(1, 1, At, B1); GE_BAR; GE_SCHED;
            GE_LDB(B0, 1, 0); GE_LDB(B1, 1, 1); GE_SCHED; GE_LDA(At, 1, 0); GE_STA(GE_SA(0, 1), a2 + hstepA, oc10, oc11);
            GE_WAIT_V(8); GE_WAIT_L(0); GE_BAR; GE_MMA(0, 0, At, B0); GE_MMA(0, 1, At, B1); GE_BAR; GE_SCHED;
            GE_LDA(At, 1, 1); GE_STB(GE_SB(1, 0), b3); GE_STB(GE_SB(1, 1), b3 + hstepB); GE_STA(GE_SA(1, 0), a3, oc00, oc01);
            GE_WAIT_V(8); GE_WAIT_L(0); GE_BAR; GE_MMA(1, 0, At, B0); GE_MMA(1, 1, At, B1); GE_BAR; GE_SCHED;
            } else {
            GE_LDB(B0, 0, 0); GE_SCHED; GE_LDA(At, 0, 0); GE_STA(GE_SA(1, 1), a1 + hstepA, oc10, oc11);
            GE_WAIT_L(8); GE_BAR; GE_WAIT_L(0); GE_MMA(0, 0, At, B0); GE_BAR; GE_SCHED;
            if constexpr (GATHER) { if (last) {
                const LAS int* tb = (const LAS int*)(lds + TAB_OFF + ((ui + 1) & 1) * 1024);
                oc00 = (unsigned)(tb[R0] >> RSH) * (unsigned)(LDA * 2) + cA0; oc01 = (unsigned)(tb[R1] >> RSH) * (unsigned)(LDA * 2) + cA1;
                oc10 = (unsigned)(tb[HALF + R0] >> RSH) * (unsigned)(LDA * 2) + cA0; oc11 = (unsigned)(tb[HALF + R1] >> RSH) * (unsigned)(LDA * 2) + cA1; } }
            GE_LDB(B1, 0, 1); GE_STB(GE_SB(0, 0), b2);
            GE_BAR; GE_WAIT_L(0); GE_MMA(0, 1, At, B1); GE_BAR;
            GE_LDA(At, 0, 1); GE_STA(GE_SA(0, 0), a2, oc00, oc01);
            GE_BAR; GE_WAIT_L(0); GE_MMA(1, 0, At, B0); GE_BAR; GE_SCHED;
            GE_STB(GE_SB(0, 1), b2 + hstepB);
            GE_WAIT_V(6); GE_BAR; GE_MMA(1, 1, At, B1); GE_BAR;
            GE_LDB(B0, 1, 0); GE_SCHED; GE_LDA(At, 1, 0); GE_STA(GE_SA(0, 1), a2 + hstepA, oc10, oc11);
            GE_WAIT_L(8); GE_BAR; GE_WAIT_L(0); GE_MMA(0, 0, At, B0); GE_BAR; GE_SCHED;
            GE_LDB(B1, 1, 1); GE_STB(GE_SB(1, 0), b3);
            GE_BAR; GE_WAIT_L(0); GE_MMA(0, 1, At, B1); GE_BAR;
            GE_LDA(At, 1, 1); GE_STA(GE_SA(1, 0), a3, oc00, oc01);
            GE_BAR; GE_WAIT_L(0); GE_MMA(1, 0, At, B0); GE_BAR; GE_SCHED;
            GE_STB(GE_SB(1, 1), b3 + hstepB);
            GE_WAIT_V(6); GE_BAR; GE_MMA(1, 1, At, B1); GE_BAR;
                    }
        }
        if (wr == 0) GE_BAR;
        if constexpr (SP2V) GE_WAIT_V(6);
        if constexpr (Epi::HAS_IDX) E(acc, cur, wr, wc, fr, fq, (const LAS int*)(lds + TAB_OFF + (ui & 1) * 1024)); else E(acc, cur, wr, wc, fr, fq);
        if (!has_next) break;
#pragma unroll
        for (int a = 0; a < 2; ++a)
#pragma unroll
            for (int b = 0; b < 2; ++b)
#pragma unroll
                for (int m = 0; m < 4; ++m)
#pragma unroll
                    for (int n = 0; n < 2; ++n) acc[a][b][m][n] = (f32x4){0.f, 0.f, 0.f, 0.f};
        cur = nxt; cA = nA; cB = nB; ++ui;
        if (wr == 1) GE_BAR;
        if constexpr (Epi::HAS_IDX) { if (wid < 4) { const int rc = trow < cur.nrows ? trow : cur.nrows - 1; glds4(uniform_ptr(E.idx_base(cur)), (unsigned)(E.idx_off(cur) + rc) * 4u, (unsigned)__builtin_amdgcn_readfirstlane(tabbase + (unsigned)((ui & 1) * 1024 + wid * 256))); } }
    }
    GE_WAIT_V(0);
    GE_BAR;
#undef GE_SA
#undef GE_SB
#undef GE_GLDS
#undef GE_STA
#undef GE_STB
#undef GE_LDA
#undef GE_LDB
#undef GE_MMA
#undef GE_WAIT_V
#undef GE_WAIT_L
#undef GE_BAR
#undef GE_SCHED
}
}
using ge::Unit;
typedef f32x4 (&AccRef)[2][2][4][2];
typedef const f32x4 (&CAccRef)[2][2][4][2];

struct SchedStatic {
    int nM, nN, G, c; const bf16_t* B; int ldb; int acol_div; int acol_bytes;
    __device__ __forceinline__ bool next(int i, Unit& u) const {
        const long L = (long)i * G + c; if (L >= (long)nM * nN) return false;
        int pm, pn; ge::static_tile(L, nM, nN, pm, pn);
        u.a_off = acol_div ? (size_t)((pn / acol_div) * acol_bytes) : 0; u.rows = nullptr; u.row0 = pm * 256; u.nrows = 256;
        u.B = B + (size_t)pn * 256 * ldb; u.pm = pm; u.pn = pn; u.x0 = 0; u.x1 = 0; return true;
    }
};

__device__ __forceinline__ u32x4 pack8(const f32x4 v0, const f32x4 v1) {
    u32x4 w; w.x = cvt_pk_bf16(v0[0], v0[1]); w.y = cvt_pk_bf16(v0[2], v0[3]); w.z = cvt_pk_bf16(v1[0], v1[1]); w.w = cvt_pk_bf16(v1[2], v1[3]); return w;
}
__device__ __forceinline__ u32x2 pack4(const f32x4 v) { u32x2 w; w.x = cvt_pk_bf16(v[0], v[1]); w.y = cvt_pk_bf16(v[2], v[3]); return w; }
__device__ __forceinline__ u32x4 dpp_x1(u32x4 v) { u32x4 r;
    r.x = (unsigned)__builtin_amdgcn_update_dpp(0, (int)v.x, 0xB1, 0xF, 0xF, true); r.y = (unsigned)__builtin_amdgcn_update_dpp(0, (int)v.y, 0xB1, 0xF, 0xF, true);
    r.z = (unsigned)__builtin_amdgcn_update_dpp(0, (int)v.z, 0xB1, 0xF, 0xF, true); r.w = (unsigned)__builtin_amdgcn_update_dpp(0, (int)v.w, 0xB1, 0xF, 0xF, true); return r; }
__device__ __forceinline__ void st_pair(bf16_t* O, size_t ld, int row, int colb0, int fr, u32x4 w0, u32x4 w1) {
    const bool odd = (fr & 1) != 0; const u32x4 send = odd ? w0 : w1, recv = dpp_x1(send);
    bf16_t* p = O + (size_t)(row - (fr & 1)) * ld + colb0 + (odd ? 32 : 0);
    *(u32x4*)p = odd ? recv : w0; *(u32x4*)(p + ld) = odd ? w1 : recv;
}
__device__ __forceinline__ u32x4 join8(u32x2 p1, u32x2 p2, bool oddq) {
    const u32x2 send = oddq ? p1 : p2; u32x2 recv;
    recv.x = (unsigned)__builtin_amdgcn_ds_swizzle((int)send.x, 0x401F); recv.y = (unsigned)__builtin_amdgcn_ds_swizzle((int)send.y, 0x401F);
    return oddq ? (u32x4){recv.x, recv.y, p2.x, p2.y} : (u32x4){p1.x, p1.y, recv.x, recv.y};
}
__device__ __forceinline__ float gelu_tanh(float x) { const float z = 1.5957691216057308f * (x + 0.044715f * x * x * x); return x * __builtin_amdgcn_rcpf(1.0f + __expf(-z)); }

struct EpiWin {
    static constexpr bool HAS_IDX = false;
    bf16_t* XBR; bf16_t* Y; const float* bias;
    __device__ __forceinline__ void operator()(CAccRef acc, const Unit& u, int wr, int wc, int fr, int fq) const {
        const int row0 = u.pm * 256 + wr * 64 + fr; const bool isy = u.pn >= 4; bf16_t* dst = isy ? Y : XBR; const int cb = (u.pn & 3) * 256, bcol = u.pn * 256, cl = 64 * wc + 8 * fq;
        f32x4 bv[2][2];
#pragma unroll
        for (int bj = 0; bj < 2; ++bj) { bv[bj][0] = *(const f32x4*)(bias + bcol + cl + 32 * bj); bv[bj][1] = *(const f32x4*)(bias + bcol + cl + 32 * bj + 4); }
#pragma unroll
        for (int ai = 0; ai < 2; ++ai)
#pragma unroll
            for (int m = 0; m < 4; ++m) { u32x4 w[2];
#pragma unroll
                for (int bj = 0; bj < 2; ++bj) { f32x4 v0 = acc[ai][bj][m][0] + bv[bj][0], v1 = acc[ai][bj][m][1] + bv[bj][1];
                    if (isy) {
#pragma unroll
                        for (int e = 0; e < 4; ++e) { v0[e] = gelu_tanh(v0[e]); v1[e] = gelu_tanh(v1[e]); } }
                    w[bj] = pack8(v0, v1); }
                st_pair(dst, 1024, row0 + 128 * ai + 16 * m, cb + cl, fr, w[0], w[1]); }
    }
};
__device__ __forceinline__ float neg_expm1_small(float x) {
    float p = 1.9841270e-4f; p = p * x + 1.3888889e-3f; p = p * x + 8.3333333e-3f; p = p * x + 4.1666667e-2f; p = p * x + 1.6666667e-1f; p = p * x + 0.5f; p = p * x + 1.0f;
    return -x * p;
}
struct EpiGates {
    static constexpr bool HAS_IDX = false;
    const bf16_t* XC; unsigned char* R8; bf16_t* U; const float* ga_b; const float* gi_b; const float* sp8t;
    __device__ __forceinline__ void operator()(CAccRef acc, const Unit& u, int wr, int wc, int fr, int fq) const {
        const int row0 = u.pm * 256 + wr * 64 + fr; const int ch = (u.pn >> 1) * 256 + (u.pn & 1) * 128 + 32 * wc + 8 * fq;
        float gab[8], gib[8], sp8[8];
#pragma unroll
        for (int j = 0; j < 8; ++j) { gab[j] = ga_b[ch + j]; gib[j] = gi_b[ch + j]; sp8[j] = sp8t[ch + j] * (2.f / 255.f); }
#pragma unroll
        for (int ai = 0; ai < 2; ++ai) {
            u32x4 xws[4];
#pragma unroll
            for (int m = 0; m < 4; ++m) xws[m] = *(const u32x4*)(XC + (size_t)(row0 + 128 * ai + 16 * m) * 1024 + ch);
#pragma unroll
            for (int m = 0; m < 4; ++m) { const size_t off = (size_t)(row0 + 128 * ai + 16 * m) * 1024 + ch;
                const u32x4 xw = xws[m];
                float xc[8] = {bflo(xw.x), bfhi(xw.x), bflo(xw.y), bfhi(xw.y), bflo(xw.z), bfhi(xw.z), bflo(xw.w), bfhi(xw.w)};
                float uu[8], x2[8], pg[8], sv[8]; unsigned rq[8]; bool far_ = false;
#pragma unroll
                for (int j = 0; j < 8; ++j) { const float ga = acc[ai][0][m][j >> 2][j & 3] + gab[j], gi = acc[ai][1][m][j >> 2][j & 3] + gib[j];
                    const float r = sigmoidf_(ga); rq[j] = (unsigned)(r * 255.f + 0.5f); pg[j] = 1.0f + __expf(-gi);
                    x2[j] = (float)rq[j] * sp8[j];
                    sv[j] = neg_expm1_small(x2[j]); far_ |= x2[j] <= -0.5f; }
                if (__any(far_)) {
#pragma unroll
                    for (int j = 0; j < 8; ++j) sv[j] = x2[j] > -0.5f ? sv[j] : 1.0f - __expf(x2[j]); }
#pragma unroll
                for (int j = 0; j < 8; ++j) uu[j] = sv[j] * __builtin_amdgcn_rsqf(fmaxf(sv[j] * pg[j] * pg[j], 1e-37f)) * xc[j];
                u32x2 wr8; u32x4 wu; wr8.x = rq[0] | (rq[1] << 8) | (rq[2] << 16) | (rq[3] << 24); wr8.y = rq[4] | (rq[5] << 8) | (rq[6] << 16) | (rq[7] << 24);
                wu.x = cvt_pk_bf16(uu[0], uu[1]); wu.y = cvt_pk_bf16(uu[2], uu[3]); wu.z = cvt_pk_bf16(uu[4], uu[5]); wu.w = cvt_pk_bf16(uu[6], uu[7]);
                *(u32x2*)(R8 + off) = wr8; *(u32x4*)(U + off) = wu; }
            asm volatile("" ::: "memory"); }
    }
};
struct EpiZ {
    static constexpr bool HAS_IDX = false;
    const bf16_t* X0; bf16_t* Z;
    __device__ __forceinline__ void operator()(CAccRef acc, const Unit& u, int wr, int wc, int fr, int fq) const {
        const int row0 = u.pm * 256 + wr * 64 + fr, col0 = u.pn * 256 + wc * 64 + 8 * fq;
        u32x4 xw[2][4][2];
#pragma unroll
        for (int ai = 0; ai < 2; ++ai)
#pragma unroll
            for (int m = 0; m < 4; ++m)
#pragma unroll
                for (int bj = 0; bj < 2; ++bj) xw[ai][m][bj] = __builtin_nontemporal_load((const u32x4*)(X0 + (size_t)(row0 + 128 * ai + 16 * m) * 1024 + col0 + bj * 32));
#pragma unroll
        for (int ai = 0; ai < 2; ++ai) {
#pragma unroll
            for (int m = 0; m < 4; ++m) { u32x4 w[2];
#pragma unroll
                for (int bj = 0; bj < 2; ++bj) { const u32x4 x = xw[ai][m][bj]; f32x4 v0, v1;
                    v0[0] = bflo(x.x); v0[1] = bfhi(x.x); v0[2] = bflo(x.y); v0[3] = bfhi(x.y); v1[0] = bflo(x.z); v1[1] = bfhi(x.z); v1[2] = bflo(x.w); v1[3] = bfhi(x.w);
                    w[bj] = pack8(v0 * DN_ALPHA + acc[ai][bj][m][0], v1 * DN_ALPHA + acc[ai][bj][m][1]); }
                st_pair(Z, 1024, row0 + 128 * ai + 16 * m, col0, fr, w[0], w[1]); }
            asm volatile("" ::: "memory"); }
    }
};
struct EpiBf16 {
    static constexpr bool HAS_IDX = false;
    bf16_t* O; int ldc;
    __device__ __forceinline__ void operator()(CAccRef acc, const Unit& u, int wr, int wc, int fr, int fq) const {
        const int row0 = u.pm * 256 + wr * 64 + fr, col0 = u.pn * 256 + wc * 64 + 8 * fq;
#pragma unroll
        for (int ai = 0; ai < 2; ++ai)
#pragma unroll
            for (int m = 0; m < 4; ++m) st_pair(O, (size_t)ldc, row0 + 128 * ai + 16 * m, col0, fr, pack8(acc[ai][0][m][0], acc[ai][0][m][1]), pack8(acc[ai][1][m][0], acc[ai][1][m][1]));
    }
};
struct EpiPle {
    static constexpr bool HAS_IDX = false;
    const bf16_t* X2; const bf16_t* PW; float* OUT; bf16_t* X3B;
    __device__ __forceinline__ void operator()(CAccRef acc, const Unit& u, int wr, int wc, int fr, int fq) const {
        const int row0 = u.pm * 256 + wr * 64 + fr, col0 = u.pn * 256 + wc * 64 + 8 * fq;
#pragma unroll
        for (int ai = 0; ai < 2; ++ai) {
            u32x4 xws[4][2], pws[4][2];
#pragma unroll
            for (int m = 0; m < 4; ++m)
#pragma unroll
                for (int bj = 0; bj < 2; ++bj) { const size_t o = (size_t)(row0 + 128 * ai + 16 * m) * 1024 + col0 + bj * 32; xws[m][bj] = *(const u32x4*)(X2 + o); pws[m][bj] = __builtin_nontemporal_load((const u32x4*)(PW + o)); }
#pragma unroll
            for (int m = 0; m < 4; ++m) { u32x4 w[2];
#pragma unroll
                for (int bj = 0; bj < 2; ++bj) { const size_t o = (size_t)(row0 + 128 * ai + 16 * m) * 1024 + col0 + bj * 32; const u32x4 xw = xws[m][bj], pw = pws[m][bj];
                    const f32x4 a0 = acc[ai][bj][m][0], a1 = acc[ai][bj][m][1]; f32x4 r0, r1;
                    r0[0] = bflo(xw.x) + bflo(pw.x) * sigmoidf_(a0[0]); r0[1] = bfhi(xw.x) + bfhi(pw.x) * sigmoidf_(a0[1]); r0[2] = bflo(xw.y) + bflo(pw.y) * sigmoidf_(a0[2]); r0[3] = bfhi(xw.y) + bfhi(pw.y) * sigmoidf_(a0[3]);
                    r1[0] = bflo(xw.z) + bflo(pw.z) * sigmoidf_(a1[0]); r1[1] = bfhi(xw.z) + bfhi(pw.z) * sigmoidf_(a1[1]); r1[2] = bflo(xw.w) + bflo(pw.w) * sigmoidf_(a1[2]); r1[3] = bfhi(xw.w) + bfhi(pw.w) * sigmoidf_(a1[3]);
                    if (OUT) { *(f32x4*)(OUT + o) = r0; *(f32x4*)(OUT + o + 4) = r1; }
                    w[bj] = pack8(r0, r1); }
                if (!OUT) st_pair(X3B, 1024, row0 + 128 * ai + 16 * m, col0, fr, w[0], w[1]); }
            asm volatile("" ::: "memory"); }
    }
};
struct EpiQ {
    static constexpr bool HAS_IDX = false;
    bf16_t* Q; const float* ROPE;
    __device__ __forceinline__ void operator()(AccRef acc, const Unit& u, int wr, int wc, int fr, int fq) const {
        const bool oddq = (fq & 1) != 0, roped = (wc & 1) == 0;
        const int row0 = u.pm * 256 + wr * 64 + fr, colb0 = u.pn * 256 + wc * 64 + (oddq ? 16 + 4 * (fq - 1) : 4 * fq); const float sc = 0.08838834764831845f;
#pragma unroll
        for (int ai = 0; ai < 2; ++ai)
#pragma unroll
            for (int m = 0; m < 4; ++m) { const int row = row0 + 128 * ai + 16 * m; const int pos = row & (SEQ - 1);
                f32x4 cs = (f32x4){1.f, 1.f, 1.f, 1.f}, sn = (f32x4){0.f, 0.f, 0.f, 0.f};
                if (roped) { cs = *(const f32x4*)(ROPE + (size_t)pos * 16 + 4 * fq); sn = *(const f32x4*)(ROPE + (size_t)SEQ * 16 + (size_t)pos * 16 + 4 * fq); }
                u32x4 w[2];
#pragma unroll
                for (int bj = 0; bj < 2; ++bj) { f32x4 x1 = acc[ai][bj][m][0], x2 = acc[ai][bj][m][1];
                    if (roped && bj == 0) { const f32x4 o1 = x1 * cs - x2 * sn, o2 = x2 * cs + x1 * sn; x1 = o1; x2 = o2; }
                    w[bj] = join8(pack4(x1 * sc), pack4(x2 * sc), oddq); }
                st_pair(Q, 1024, row, colb0, fr, w[0], w[1]); }
    }
};
struct EpiKV {
    static constexpr bool HAS_IDX = false;
    bf16_t* KB; bf16_t* VB; const float* ROPE; float* KM;
    __device__ __forceinline__ void operator()(AccRef acc, const Unit& u, int wr, int wc, int fr, int fq) const {
        const bool isv = u.pn >= 4, oddq = (fq & 1) != 0, roped = !isv && (wc & 1) == 0;
        const int row0 = u.pm * 256 + wr * 64 + fr, colb0 = (u.pn & 3) * 256 + wc * 64 + (oddq ? 16 + 4 * (fq - 1) : 4 * fq);
        bf16_t* dst = isv ? VB : KB;
        f32x4 csum[2][2];
#pragma unroll
        for (int bj = 0; bj < 2; ++bj)
#pragma unroll
            for (int n = 0; n < 2; ++n) csum[bj][n] = (f32x4){0.f, 0.f, 0.f, 0.f};
#pragma unroll
        for (int ai = 0; ai < 2; ++ai)
#pragma unroll
            for (int m = 0; m < 4; ++m) { const int row = row0 + 128 * ai + 16 * m; const int pos = row & (SEQ - 1);
                f32x4 cs = (f32x4){1.f, 1.f, 1.f, 1.f}, sn = (f32x4){0.f, 0.f, 0.f, 0.f};
                if (roped) { cs = *(const f32x4*)(ROPE + (size_t)pos * 16 + 4 * fq); sn = *(const f32x4*)(ROPE + (size_t)SEQ * 16 + (size_t)pos * 16 + 4 * fq); }
                u32x4 w[2];
#pragma unroll
                for (int bj = 0; bj < 2; ++bj) { f32x4 x1 = acc[ai][bj][m][0], x2 = acc[ai][bj][m][1];
                    if (roped && bj == 0) { const f32x4 o1 = x1 * cs - x2 * sn, o2 = x2 * cs + x1 * sn; x1 = o1; x2 = o2; }
                    csum[bj][0] += x1; csum[bj][1] += x2;
                    w[bj] = join8(pack4(x1), pack4(x2), oddq); }
                st_pair(dst, 1024, row, colb0, fr, w[0], w[1]); }
        if (!isv) {
            const int b = u.pm >> 6, blk = u.pm & 63, head = (u.pn & 3) * 2 + (wc >> 1);
#pragma unroll
            for (int bj = 0; bj < 2; ++bj)
#pragma unroll
                for (int n = 0; n < 2; ++n)
#pragma unroll
                    for (int e = 0; e < 4; ++e) { float s = row_sum16(csum[bj][n][e]);
                        if (fr == 0) { const int d = 64 * (wc & 1) + 32 * bj + 16 * n + 4 * fq + e; atomicAdd(KM + ((size_t)((b * 8 + head) * 64 + blk)) * 128 + d, s); } }
        }
    }
};

__device__ __forceinline__ void transpose_item(const float* W, int K, int N, bf16_t* WT, int k0, int n0, int drow0, LAS float* scr, int lane) {
    float wv[32];
#pragma unroll
    for (int i = 0; i < 32; ++i) wv[i] = __builtin_nontemporal_load(W + (size_t)(k0 + 2 * i + (lane >> 5)) * N + n0 + (lane & 31));
#pragma unroll
    for (int i = 0; i < 32; ++i) scr[(2 * i + (lane >> 5)) * 33 + (lane & 31)] = wv[i];
    LDS_WAIT(); asm volatile("" ::: "memory");
    const int c = lane & 7;
#pragma unroll
    for (int j = 0; j < 4; ++j) { const int n = (lane >> 3) + 8 * j; const LAS float* s = scr + (8 * c) * 33 + n;
        u32x4 o; o.x = cvt_pk_bf16(s[0 * 33], s[1 * 33]); o.y = cvt_pk_bf16(s[2 * 33], s[3 * 33]); o.z = cvt_pk_bf16(s[4 * 33], s[5 * 33]); o.w = cvt_pk_bf16(s[6 * 33], s[7 * 33]);
        *(u32x4*)(WT + (size_t)(drow0 + n) * K + k0 + 8 * c) = o; }
    LDS_WAIT(); asm volatile("" ::: "memory");
}
__device__ __forceinline__ void conv_job(const float* src, bf16_t* dst, int K, int N, int nb, size_t dstride, int mode, int& base, int gw, int NGW, LAS float* scr, int lane) {
    const int nkb = K / 64, nnb = N / 32, per = nkb * nnb, count = per * nb;
    int first = (gw - base) % NGW; if (first < 0) first += NGW;
    for (int it = first; it < count; it += NGW) {
        const int b = it / per, r = it % per, kb = r / nnb, nb_ = r % nnb, n0 = nb_ * 32;
        const int drow = mode == 0 ? n0 : ((n0 >> 7) * 256 + (mode == 2 ? 128 : 0) + (n0 & 127));
        transpose_item(src + (size_t)b * K * N, K, N, dst + (size_t)b * dstride, kb * 64, n0, drow, scr, lane);
    }
    base = (base + count) % NGW;
}
__device__ __forceinline__ void cvt_f32_bf16(const float* src, bf16_t* dst, size_t n8, size_t gtid, size_t gthreads) {
    for (size_t i = gtid; i < n8; i += gthreads) { const f32x4 a = __builtin_nontemporal_load((const f32x4*)(src + i * 8)), b = __builtin_nontemporal_load((const f32x4*)(src + i * 8 + 4)); *(u32x4*)(dst + i * 8) = pack8(a, b); }
}

__device__ __forceinline__ void ln_rows(f32x4 (&v)[4], const f32x4 (&g)[4], const f32x4 (&b)[4]) {
    float s = 0.f, s2 = 0.f;
#pragma unroll
    for (int j = 0; j < 4; ++j) { s += (v[j][0] + v[j][1]) + (v[j][2] + v[j][3]); s2 += (v[j][0] * v[j][0] + v[j][1] * v[j][1]) + (v[j][2] * v[j][2] + v[j][3] * v[j][3]); }
    wave_sum2(s, s2);
    const float mean = s * (1.f / 1024.f); const float var = fmaxf(s2 * (1.f / 1024.f) - mean * mean, 0.f);
    const float rstd = 1.0f / sqrtf(var + LN_EPS);
#pragma unroll
    for (int j = 0; j < 4; ++j) v[j] = (v[j] - mean) * rstd * g[j] + b[j];
}

__device__ __forceinline__ void phase_conv(const bf16_t* XBR, bf16_t* XC, const float* cw  , const float* cb, int gw, int NGW, int lane) {
    for (int it = gw; it < 2048; it += NGW) {
        const int chunk = it >> 1, ch = (it & 1) * 512 + lane * 8, t0 = chunk * 32;
        float w[4][8], bia[8];
#pragma unroll
        for (int k = 0; k < 4; ++k)
#pragma unroll
            for (int j = 0; j < 8; ++j) w[k][j] = cw[k * 1024 + ch + j];
#pragma unroll
        for (int j = 0; j < 8; ++j) bia[j] = cb[ch + j];
        float x0[8], x1[8], x2[8];
        const bool has_prev = (t0 & (SEQ - 1)) != 0;
        u32x4 p0 = (u32x4){0u, 0u, 0u, 0u}, p1 = p0, p2 = p0;
        if (has_prev) { p0 = *(const u32x4*)(XBR + (size_t)(t0 - 3) * 1024 + ch); p1 = *(const u32x4*)(XBR + (size_t)(t0 - 2) * 1024 + ch); p2 = *(const u32x4*)(XBR + (size_t)(t0 - 1) * 1024 + ch); }
#define UNPK(dst, w4) do { dst[0] = bflo(w4.x); dst[1] = bfhi(w4.x); dst[2] = bflo(w4.y); dst[3] = bfhi(w4.y); dst[4] = bflo(w4.z); dst[5] = bfhi(w4.z); dst[6] = bflo(w4.w); dst[7] = bfhi(w4.w); } while (0)
        UNPK(x0, p0); UNPK(x1, p1); UNPK(x2, p2);
#pragma unroll 1
        for (int rb = 0; rb < 32; rb += 8) {
            u32x4 in8[8];
#pragma unroll
            for (int r = 0; r < 8; ++r) in8[r] = __builtin_nontemporal_load((const u32x4*)(XBR + (size_t)(t0 + rb + r) * 1024 + ch));
#pragma unroll
            for (int r = 0; r < 8; ++r) { float x3[8]; UNPK(x3, in8[r]); float o[8];
#pragma unroll
                for (int j = 0; j < 8; ++j) { o[j] = bia[j] + x0[j] * w[0][j] + x1[j] * w[1][j] + x2[j] * w[2][j] + x3[j] * w[3][j]; x0[j] = x1[j]; x1[j] = x2[j]; x2[j] = x3[j]; }
                u32x4 ow; ow.x = cvt_pk_bf16(o[0], o[1]); ow.y = cvt_pk_bf16(o[2], o[3]); ow.z = cvt_pk_bf16(o[4], o[5]); ow.w = cvt_pk_bf16(o[6], o[7]);
                *(u32x4*)(XC + (size_t)(t0 + rb + r) * 1024 + ch) = ow; }
        }
    }
}
#define SC_LA4(l, w, s4) const float l##0 = (float)((w) & 0xffu) * s4[0], l##1 = (float)(((w) >> 8) & 0xffu) * s4[1], l##2 = (float)(((w) >> 16) & 0xffu) * s4[2], l##3 = (float)((w) >> 24) * s4[3]
__device__ __forceinline__ void phase_scan1(const unsigned char* R8, const bf16_t* U, const float* sp8t, float* CH, float* CL, int gw, int NGW, int lane) {
    for (int it = gw; it < 2048; it += NGW) {
        const int chunk = it >> 2, ch = (it & 3) * 256 + lane * 4, t0 = chunk * 64;
        const f32x4 s4 = *(const f32x4*)(sp8t + ch) * (1.f / 255.f);
        float h[4] = {0.f, 0.f, 0.f, 0.f}, ls[4] = {0.f, 0.f, 0.f, 0.f};
#pragma unroll 1
        for (int rb = 0; rb < 64; rb += 16) {
            unsigned lw[16]; u32x2 uw[16];
#pragma unroll
            for (int r = 0; r < 16; ++r) { lw[r] = *(const unsigned*)(R8 + (size_t)(t0 + rb + r) * 1024 + ch); uw[r] = *(const u32x2*)(U + (size_t)(t0 + rb + r) * 1024 + ch); }
#pragma unroll
            for (int r = 0; r < 16; ++r) { SC_LA4(l, lw[r], s4);
                h[0] = __expf(l0) * h[0] + bflo(uw[r].x); h[1] = __expf(l1) * h[1] + bfhi(uw[r].x); h[2] = __expf(l2) * h[2] + bflo(uw[r].y); h[3] = __expf(l3) * h[3] + bfhi(uw[r].y);
                ls[0] += l0; ls[1] += l1; ls[2] += l2; ls[3] += l3; }
        }
        *(f32x4*)(CH + (size_t)chunk * 1024 + ch) = (f32x4){h[0], h[1], h[2], h[3]}; *(f32x4*)(CL + (size_t)chunk * 1024 + ch) = (f32x4){ls[0], ls[1], ls[2], ls[3]};
    }
}
__device__ __forceinline__ void phase_scan_carry(const float* CH, const float* CL, float* CIN, int tid, LAS unsigned char* lds, int G) {
    asm volatile("" : "+v"(tid)); const int wave = __builtin_amdgcn_readfirstlane(tid >> 6), lane = tid & 63;
    LAS float* agg = (LAS float*)lds;
    for (int g = blockIdx.x; g < 32; g += G) {
        const int b = g >> 4, ch = (g & 15) * 64 + lane;
        const size_t o0 = (size_t)(b * 256 + wave * 32) * 1024 + ch;
        float av[32], hv[32];
#pragma unroll
        for (int c = 0; c < 32; ++c) { av[c] = CL[o0 + (size_t)c * 1024]; hv[c] = CH[o0 + (size_t)c * 1024]; }
        float A = 1.f, H = 0.f;
#pragma unroll
        for (int c = 0; c < 32; ++c) { av[c] = __expf(av[c]); H = av[c] * H + hv[c]; A *= av[c]; }
        agg[(wave * 2) * 64 + lane] = A; agg[(wave * 2 + 1) * 64 + lane] = H;
        __syncthreads();
        float h = 0.f;
        for (int w = 0; w < wave; ++w) h = agg[(w * 2) * 64 + lane] * h + agg[(w * 2 + 1) * 64 + lane];
#pragma unroll
        for (int c = 0; c < 32; ++c) { CIN[o0 + (size_t)c * 1024] = h; h = av[c] * h + hv[c]; }
        __syncthreads();
    }
}
__device__ __forceinline__ void phase_scan2(const unsigned char* R8, const bf16_t* U, const bf16_t* Y, const float* sp8t, const float* CIN, bf16_t* HY, int gw, int NGW, int lane) {
    for (int it = gw; it < 2048; it += NGW) {
        const int chunk = it >> 2, ch = (it & 3) * 256 + lane * 4, t0 = chunk * 64;
        const f32x4 s4 = *(const f32x4*)(sp8t + ch) * (1.f / 255.f);
        const f32x4 hin = *(const f32x4*)(CIN + (size_t)chunk * 1024 + ch); float h[4] = {hin[0], hin[1], hin[2], hin[3]};
#pragma unroll 1
        for (int rb = 0; rb < 64; rb += 16) {
            unsigned lw[16]; u32x2 uw[16], yw[16];
#pragma unroll
            for (int r = 0; r < 16; ++r) { const size_t o = (size_t)(t0 + rb + r) * 1024 + ch; lw[r] = __builtin_nontemporal_load((const unsigned*)(R8 + o)); uw[r] = __builtin_nontemporal_load((const u32x2*)(U + o)); yw[r] = __builtin_nontemporal_load((const u32x2*)(Y + o)); }
#pragma unroll
            for (int r = 0; r < 16; ++r) { const size_t o = (size_t)(t0 + rb + r) * 1024 + ch; SC_LA4(l, lw[r], s4);
                h[0] = __expf(l0) * h[0] + bflo(uw[r].x); h[1] = __expf(l1) * h[1] + bfhi(uw[r].x); h[2] = __expf(l2) * h[2] + bflo(uw[r].y); h[3] = __expf(l3) * h[3] + bfhi(uw[r].y);
                u32x2 ow; ow.x = cvt_pk_bf16(h[0] * bflo(yw[r].x), h[1] * bfhi(yw[r].x)); ow.y = cvt_pk_bf16(h[2] * bflo(yw[r].y), h[3] * bfhi(yw[r].y)); *(u32x2*)(HY + o) = ow; }
        }
    }
}
#undef SC_LA4

constexpr int R1_ROWB = 1040, R1_WAVEB = 16 * R1_ROWB;
__device__ __forceinline__ void phase_r1(int tid, const float* lng, const float* lnb, bf16_t* X1B, const bf16_t* Wr, const float* rbias,
                                         unsigned* ecnt, int* elist, float* wpair, int* ppos, LAS unsigned char* lds, int G) {
    asm volatile("" : "+v"(tid)); const int wave = __builtin_amdgcn_readfirstlane(tid >> 6), lane = tid & 63;
    LAS unsigned* hist = (LAS unsigned*)(lds + MISC_OFF + MS_TAB); LAS unsigned* basev = hist + 64;
    LAS unsigned char* xw = lds + wave * R1_WAVEB;
    f32x4 g[4], bb[4];
#pragma unroll
    for (int j = 0; j < 4; ++j) { const int c = 8 * lane + 512 * (j >> 1) + 4 * (j & 1); g[j] = *(const f32x4*)(lng + c); bb[j] = *(const f32x4*)(lnb + c); }
    for (int rb = blockIdx.x; rb < NTOK / 128; rb += G) {
        if (tid < 64) hist[tid] = 0u;
        __syncthreads();
        const size_t row0 = (size_t)rb * 128 + wave * 16;
        u32x4 hi2[16];
#pragma unroll
        for (int rh = 0; rh < 2; ++rh) {
            u32x4 zin[8][2];
#pragma unroll
            for (int rr = 0; rr < 8; ++rr)
#pragma unroll
                for (int jj = 0; jj < 2; ++jj) zin[rr][jj] = *(const u32x4*)(X1B + (row0 + rh * 8 + rr) * 1024 + 8 * lane + 512 * jj);
#pragma unroll
            for (int rr = 0; rr < 8; ++rr) { const int r = rh * 8 + rr; f32x4 v[4];
#pragma unroll
                for (int jj = 0; jj < 2; ++jj) { const u32x4 zw = zin[rr][jj]; v[2 * jj] = (f32x4){bflo(zw.x), bfhi(zw.x), bflo(zw.y), bfhi(zw.y)}; v[2 * jj + 1] = (f32x4){bflo(zw.z), bfhi(zw.z), bflo(zw.w), bfhi(zw.w)}; }
                ln_rows(v, g, bb);
#pragma unroll
                for (int jj = 0; jj < 2; ++jj) { const u32x4 w = pack8(v[2 * jj], v[2 * jj + 1]); *(u32x4*)(X1B + (row0 + r) * 1024 + 8 * lane + 512 * jj) = w;
                    if (jj == 0) *(LAS u32x4*)(xw + r * R1_ROWB + (8 * lane) * 2) = w; else hi2[r] = w; }
            }
        }
        LDS_WAIT(); asm volatile("" ::: "memory");
        f32x4 acc[4];
#pragma unroll
        for (int q = 0; q < 4; ++q) acc[q] = (f32x4){0.f, 0.f, 0.f, 0.f};
#pragma unroll
        for (int kh = 0; kh < 2; ++kh) {
            if (kh == 1) {
                asm volatile("" ::: "memory");
#pragma unroll
                for (int r = 0; r < 16; ++r) *(LAS u32x4*)(xw + r * R1_ROWB + (8 * lane) * 2) = hi2[r];
                LDS_WAIT(); asm volatile("" ::: "memory");
            }
#pragma unroll 4
            for (int ks = 0; ks < 16; ++ks) {
                const bf16x8 a = *(const LAS bf16x8*)(xw + (lane & 15) * R1_ROWB + (ks * 32 + 8 * (lane >> 4)) * 2);
#pragma unroll
                for (int q = 0; q < 4; ++q) { const bf16x8 b = *(const bf16x8*)(Wr + (size_t)(16 * q + (lane & 15)) * 1024 + kh * 512 + ks * 32 + 8 * (lane >> 4));
                    acc[q] = __builtin_amdgcn_mfma_f32_16x16x32_bf16(a, b, acc[q], 0, 0, 0); }
            }
            LDS_WAIT();
        }
        asm volatile("" ::: "memory");
        LAS float* ss = (LAS float*)xw; LAS float* sc = ss + 1024;
#pragma unroll
        for (int q = 0; q < 4; ++q) { const int e = 16 * q + (lane & 15); const float rbv = rbias[e];
#pragma unroll
            for (int r = 0; r < 4; ++r) { const int trow = 4 * (lane >> 4) + r; const float s = sigmoidf_(acc[q][r]); ss[trow * 64 + e] = s; sc[trow * 64 + e] = s + rbv; } }
        LDS_WAIT(); asm volatile("" ::: "memory");
        const int trow = lane >> 2, part = lane & 3;
        int e_m0 = 0, e_m1 = 0; float w_m0 = 0.f, w_m1 = 0.f;
        {
            const LAS float* cp = sc + trow * 64 + 16 * part; const LAS float* s0 = ss + trow * 64;
            const float NEG = -__builtin_inff();
            float c[16];
#pragma unroll
            for (int q = 0; q < 4; ++q) { const f32x4 t4 = *(const LAS f32x4*)(cp + 4 * q); c[4 * q] = t4[0]; c[4 * q + 1] = t4[1]; c[4 * q + 2] = t4[2]; c[4 * q + 3] = t4[3]; }
            float gsv[2];
#pragma unroll
            for (int gi = 0; gi < 2; ++gi) { float m1 = NEG, m2 = NEG;
#pragma unroll
                for (int j = 0; j < 8; ++j) { const float x = c[gi * 8 + j]; const float nm1 = fmaxf(m1, x); m2 = fmaxf(m2, fminf(m1, x)); m1 = nm1; }
                gsv[gi] = m1 + m2; }
            float gs[8];
#define QB(v, P) __int_as_float(__builtin_amdgcn_update_dpp(0, __float_as_int(v), (P) * 0x55, 0xF, 0xF, true))
            gs[0] = QB(gsv[0], 0); gs[1] = QB(gsv[1], 0); gs[2] = QB(gsv[0], 1); gs[3] = QB(gsv[1], 1); gs[4] = QB(gsv[0], 2); gs[5] = QB(gsv[1], 2); gs[6] = QB(gsv[0], 3); gs[7] = QB(gsv[1], 3);
#undef QB
            unsigned gmask = 0u;
#pragma unroll
            for (int it = 0; it < 4; ++it) { float best = NEG; int bi = 0;
#pragma unroll
                for (int gi = 0; gi < 8; ++gi) { const bool free_ = ((gmask >> gi) & 1u) == 0u; if (free_ && gs[gi] > best) { best = gs[gi]; bi = gi; } }
                gmask |= 1u << bi; }
            unsigned taken = (((gmask >> (2 * part)) & 1u) ? 0u : 0xffu) | (((gmask >> (2 * part + 1)) & 1u) ? 0u : 0xff00u);
            int e_all[8];
#pragma unroll
            for (int k = 0; k < 8; ++k) { float best = NEG; int bi = 0;
#pragma unroll
                for (int e2 = 0; e2 < 16; ++e2) { const bool free_ = ((taken >> e2) & 1u) == 0u; if (free_ && c[e2] > best) { best = c[e2]; bi = e2; } }
                int ge = 16 * part + bi;
                {   const float ov = __int_as_float(__builtin_amdgcn_update_dpp(0, __float_as_int(best), 0xB1, 0xF, 0xF, true)); const int oi = __builtin_amdgcn_update_dpp(0, ge, 0xB1, 0xF, 0xF, true);
                    const bool take = ov > best || (ov == best && oi < ge); best = take ? ov : best; ge = take ? oi : ge; }
                {   const float ov = __int_as_float(__builtin_amdgcn_update_dpp(0, __float_as_int(best), 0x4E, 0xF, 0xF, true)); const int oi = __builtin_amdgcn_update_dpp(0, ge, 0x4E, 0xF, 0xF, true);
                    const bool take = ov > best || (ov == best && oi < ge); best = take ? ov : best; ge = take ? oi : ge; }
                taken |= ((ge >> 4) == part) ? (1u << (ge & 15)) : 0u;
                e_all[k] = ge; }
            float w_all[8]; float wsum = 0.f;
#pragma unroll
            for (int k = 0; k < 8; ++k) w_all[k] = s0[e_all[k]];
#pragma unroll
            for (int k = 0; k < 8; ++k) wsum += w_all[k];
            const float inv = 2.5f / wsum;
#pragma unroll
            for (int k = 0; k < 8; ++k) { const bool mine = part == (k >> 1);
                if (k & 1) { e_m1 = mine ? e_all[k] : e_m1; w_m1 = mine ? w_all[k] * inv : w_m1; } else { e_m0 = mine ? e_all[k] : e_m0; w_m0 = mine ? w_all[k] * inv : w_m0; } }
        }
        LDS_WAIT(); asm volatile("" ::: "memory");
        const int slot0 = (int)__hip_atomic_fetch_add((LAS unsigned*)&hist[e_m0], 1u, __ATOMIC_RELAXED, __HIP_MEMORY_SCOPE_WORKGROUP);
        const int slot1 = (int)__hip_atomic_fetch_add((LAS unsigned*)&hist[e_m1], 1u, __ATOMIC_RELAXED, __HIP_MEMORY_SCOPE_WORKGROUP);
        __syncthreads();
        if (tid < 64) basev[tid] = __hip_atomic_fetch_add(ecnt + tid, hist[tid], __ATOMIC_RELAXED, __HIP_MEMORY_SCOPE_AGENT);
        __syncthreads();
        {   const int token = rb * 128 + wave * 16 + trow, pair = token * 8 + 2 * part;
            const int pos0 = (int)basev[e_m0] + slot0, pos1 = (int)basev[e_m1] + slot1;
            elist[(size_t)e_m0 * 32768 + pos0] = pair; elist[(size_t)e_m1 * 32768 + pos1] = pair + 1;
            *(f32x2*)(wpair + pair) = (f32x2){w_m0, w_m1}; *(u32x2*)(ppos + pair) = (u32x2){(unsigned)((e_m0 << 20) | pos0), (unsigned)((e_m1 << 20) | pos1)}; }
        __syncthreads();
    }
}

struct MoeTab { LAS int* tstart; LAS int* sbase; LAS int* scnt; LAS unsigned char* tseg; };
template <bool TSEG> __device__ __forceinline__ MoeTab moe_tables(int tid, unsigned* ecnt, LAS unsigned char* lds) {
    MoeTab T; T.tstart = (LAS int*)(lds + MISC_OFF + MS_TAB); T.sbase = T.tstart + 132; T.scnt = T.sbase + 132; T.tseg = lds + MISC_OFF + 4096;

    __syncthreads();
    if (tid < 64) T.scnt[tid] = (int)__hip_atomic_load(ecnt + tid, __ATOMIC_RELAXED, __HIP_MEMORY_SCOPE_AGENT);
    __syncthreads();
    if (tid < 64) {
        int t = 0, s = 0;
#pragma unroll
        for (int q = 0; q < 16; ++q) { const i32x4 c4 = *(const LAS i32x4*)(T.scnt + 4 * q);
#pragma unroll
            for (int e = 0; e < 4; ++e) { const bool below = (4 * q + e) < tid; const int tl = (c4[e] + 255) >> 8; t += below ? tl : 0; s += below ? (tl << 8) : 0; } }
        T.tstart[tid] = t; T.sbase[tid] = s;
        if (tid == 63) { const int c = T.scnt[63]; T.tstart[64] = t + ((c + 255) >> 8); T.sbase[64] = s + (((c + 255) >> 8) << 8); } }
    __syncthreads();
    if constexpr (TSEG) {
        const int TR = T.tstart[64];
        for (int tile = tid; tile < TR; tile += NTHR) { int lo = 0, hi = 64;
#pragma unroll
            for (int it = 0; it < 6; ++it) { const int mid = (lo + hi) >> 1; const bool ge = T.tstart[mid] <= tile; lo = ge ? mid : lo; hi = ge ? hi : mid; }
            T.tseg[tile] = (unsigned char)lo; }
        __syncthreads();
    }
    return T;
}
__device__ __forceinline__ int moe_find_seg(const MoeTab& T, int tile) { return (int)T.tseg[tile]; }
struct SchedMoe1 {
    MoeTab T; int G, c; const int* elist; const bf16_t* egu; const bf16_t* shgu; const int* idl;
    __device__ __forceinline__ bool next(int i, Unit& u) const {
        const int TR = T.tstart[64]; const long L = (long)i * G + c; if (L >= (long)(TR + 128) * 2) return false;
        const int tile = (int)(L >> 1), jn = (int)(L & 1); u.a_off = 0; u.pn = jn; u.x1 = 0;
        if (tile < TR) { const int seg = moe_find_seg(T, tile), mt = tile - T.tstart[seg], cnt = T.scnt[seg];
            u.rows = elist + (size_t)seg * 32768 + mt * 256; u.row0 = 0; u.nrows = (cnt - mt * 256) < 256 ? (cnt - mt * 256) : 256;
            u.B = egu + ((size_t)seg * 512 + jn * 256) * 1024; u.pm = T.sbase[seg] + mt * 256; u.x0 = 0;
        } else { const int mt = tile - TR; u.rows = idl + mt * 256; u.row0 = mt * 256; u.nrows = 256; u.B = shgu + (size_t)jn * 256 * 1024; u.pm = mt * 256; u.x0 = 1; }
        return true;
    }
};
struct EpiMoe1 {
    static constexpr bool HAS_IDX = false;
    bf16_t* HDN; bf16_t* HSH;
    __device__ __forceinline__ void operator()(CAccRef acc, const Unit& u, int wr, int wc, int fr, int fq) const {
        bf16_t* out = u.x0 ? HSH : HDN; const int cl = u.pn * 128 + 32 * wc + 8 * fq;
#pragma unroll
        for (int ai = 0; ai < 2; ++ai)
#pragma unroll
            for (int m = 0; m < 4; ++m) { const int r = 128 * ai + 64 * wr + 16 * m + fr;
                if (r < u.nrows) { f32x4 h0, h1;
#pragma unroll
                    for (int e = 0; e < 4; ++e) { const float g0 = acc[ai][0][m][0][e], g1 = acc[ai][0][m][1][e];
                        h0[e] = g0 * sigmoidf_(g0) * acc[ai][1][m][0][e]; h1[e] = g1 * sigmoidf_(g1) * acc[ai][1][m][1][e]; }
                    const int rg = u.pm + r;
                    *(u32x4*)(out + (size_t)(rg >> 1) * 512 + (u.pn * 4 + wc) * 64 + (rg & 1) * 32 + 8 * fq) = pack8(h0, h1); } asm volatile("" ::: "memory"); }
    }
};
struct SchedMoe2 {
    MoeTab T; int G, c; const int* elist; const bf16_t* ed; const bf16_t* shd;
    __device__ __forceinline__ bool next(int i, Unit& u) const {
        const int T0 = 0, TH = T.tstart[64], TS = 128;
        const long L = (long)i * G + c; if (L >= (long)(TH + TS) * 4) return false;
        const int tile = (int)(L >> 2), pn = (int)(L & 3); u.pn = pn; u.rows = nullptr; u.pm = 0;
        if (tile < TH) { const int seg = moe_find_seg(T, T0 + tile), mt = T0 + tile - T.tstart[seg], cnt = T.scnt[seg];
            u.a_off = 0; u.row0 = T.sbase[seg] + mt * 256; u.nrows = (cnt - mt * 256) < 256 ? (cnt - mt * 256) : 256;
            u.B = ed + ((size_t)seg * 1024 + pn * 256) * 256; u.x0 = 0; u.x1 = seg * 32768 + mt * 256;
        } else { const int mt = tile - TH; u.a_off = WS_HSH - WS_HDN; u.row0 = mt * 256; u.nrows = 256; u.B = shd + (size_t)pn * 256 * 256; u.x0 = 1; u.x1 = mt * 256; }
        return true;
    }
};
__device__ __forceinline__ unsigned pk4_fp8(float a, float b, float c, float d) { int w = __builtin_amdgcn_cvt_pk_fp8_f32(a, b, 0, false); w = __builtin_amdgcn_cvt_pk_fp8_f32(c, d, w, true); return (unsigned)w; }
struct EpiMoe2 {
    static constexpr bool HAS_IDX = false;
    unsigned char* YP; unsigned char* YSH;
    __device__ __forceinline__ void operator()(CAccRef acc, const Unit& u, int wr, int wc, int fr, int fq) const {
        const int cl = u.pn * 256 + 64 * wc + 16 * fq;
        unsigned char* base = (unsigned char*)((uintptr_t)YP + (uintptr_t)(unsigned)u.x0 * ((uintptr_t)YSH - (uintptr_t)YP)) + (size_t)u.row0 * 1024;
#pragma unroll
        for (int ai = 0; ai < 2; ++ai)
#pragma unroll
            for (int m = 0; m < 4; ++m) { const int r = 128 * ai + 64 * wr + 16 * m + fr;
                const f32x4 a0 = acc[ai][0][m][0] * 16.f, a1 = acc[ai][0][m][1] * 16.f, b0 = acc[ai][1][m][0] * 16.f, b1 = acc[ai][1][m][1] * 16.f;
                u32x4 w; w.x = pk4_fp8(a0[0], a0[1], a0[2], a0[3]); w.y = pk4_fp8(a1[0], a1[1], a1[2], a1[3]); w.z = pk4_fp8(b0[0], b0[1], b0[2], b0[3]); w.w = pk4_fp8(b1[0], b1[1], b1[2], b1[3]);
                if (r < u.nrows) *(u32x4*)(base + (size_t)r * 1024 + cl) = w; }
    }
};
struct GB16 { float g[16], b[16]; };
__device__ __forceinline__ GB16 load_gb16(const float* lng, const float* lnb, int lane) { GB16 r;
#pragma unroll
    for (int q = 0; q < 4; ++q) { const f32x4 g = *(const f32x4*)(lng + 16 * lane + 4 * q), b = *(const f32x4*)(lnb + 16 * lane + 4 * q);
#pragma unroll
        for (int e = 0; e < 4; ++e) { r.g[4 * q + e] = g[e]; r.b[4 * q + e] = b[e]; } }
    return r; }
__device__ __forceinline__ void ln16(float (&v)[16], const GB16& gb) {
    float s = 0.f, s2 = 0.f;
#pragma unroll
    for (int j = 0; j < 16; ++j) { s += v[j]; s2 += v[j] * v[j]; }
    wave_sum2(s, s2);
    const float mean = s * (1.f / 1024.f); const float var = fmaxf(s2 * (1.f / 1024.f) - mean * mean, 0.f);
    const float rstd = 1.0f / sqrtf(var + LN_EPS);
#pragma unroll
    for (int j = 0; j < 16; ++j) v[j] = (v[j] - mean) * rstd * gb.g[j] + gb.b[j];
}
__device__ __forceinline__ void ld16_bf16(float (&v)[16], const bf16_t* p) { const u32x4 a = *(const u32x4*)p, b = *(const u32x4*)(p + 8);
    v[0] = bflo(a.x); v[1] = bfhi(a.x); v[2] = bflo(a.y); v[3] = bfhi(a.y); v[4] = bflo(a.z); v[5] = bfhi(a.z); v[6] = bflo(a.w); v[7] = bfhi(a.w);
    v[8] = bflo(b.x); v[9] = bfhi(b.x); v[10] = bflo(b.y); v[11] = bfhi(b.y); v[12] = bflo(b.z); v[13] = bfhi(b.z); v[14] = bflo(b.w); v[15] = bfhi(b.w); }
__device__ __forceinline__ void st16_bf16(bf16_t* p, const float (&v)[16]) { u32x4 a, b;
    a.x = cvt_pk_bf16(v[0], v[1]); a.y = cvt_pk_bf16(v[2], v[3]); a.z = cvt_pk_bf16(v[4], v[5]); a.w = cvt_pk_bf16(v[6], v[7]);
    b.x = cvt_pk_bf16(v[8], v[9]); b.y = cvt_pk_bf16(v[10], v[11]); b.z = cvt_pk_bf16(v[12], v[13]); b.w = cvt_pk_bf16(v[14], v[15]); *(u32x4*)p = a; *(u32x4*)(p + 8) = b; }
__device__ __forceinline__ void fma16_fp8(float (&v)[16], const u32x4 w, float s) {
    const unsigned ww[4] = {w.x, w.y, w.z, w.w};
#pragma unroll
    for (int q = 0; q < 4; ++q) { const f32x2 lo = __builtin_amdgcn_cvt_pk_f32_fp8((int)ww[q], false), hi = __builtin_amdgcn_cvt_pk_f32_fp8((int)ww[q], true);
        v[4 * q] += s * lo[0]; v[4 * q + 1] += s * lo[1]; v[4 * q + 2] += s * hi[0]; v[4 * q + 3] += s * hi[1]; }
}
__device__ __forceinline__ void phase_m4(const float* lng, const float* lnb, bf16_t* X, const unsigned char* YP, const unsigned char* YSH, const float* wpair, const int* ppos, const LAS int* sbase, int gw, int NGW, int lane) {
    const GB16 gb = load_gb16(lng, lnb, lane);
    for (int tl0 = 2 * gw; tl0 < NTOK; tl0 += 2 * NGW) {
        u32x4 xa[2], xb[2], ys[2], yw[2][8]; f32x4 w03[2], w47[2]; int pp[2][8];
#pragma unroll
        for (int q = 0; q < 2; ++q) { const size_t row = (size_t)tl0 + q;
            const u32x4 p0 = __builtin_nontemporal_load((const u32x4*)(ppos + row * 8)), p1 = __builtin_nontemporal_load((const u32x4*)(ppos + row * 8 + 4));
            pp[q][0] = (int)p0.x; pp[q][1] = (int)p0.y; pp[q][2] = (int)p0.z; pp[q][3] = (int)p0.w; pp[q][4] = (int)p1.x; pp[q][5] = (int)p1.y; pp[q][6] = (int)p1.z; pp[q][7] = (int)p1.w;
            xa[q] = *(const u32x4*)(X + row * 1024 + 16 * lane); xb[q] = *(const u32x4*)(X + row * 1024 + 16 * lane + 8); ys[q] = __builtin_nontemporal_load((const u32x4*)(YSH + row * 1024 + 16 * lane));
            w03[q] = __builtin_nontemporal_load((const f32x4*)(wpair + row * 8)); w47[q] = __builtin_nontemporal_load((const f32x4*)(wpair + row * 8 + 4)); }
#pragma unroll
        for (int q = 0; q < 2; ++q)
#pragma unroll
            for (int k = 0; k < 8; ++k) { const int yrow = sbase[pp[q][k] >> 20] + (pp[q][k] & 0xfffff); yw[q][k] = __builtin_nontemporal_load((const u32x4*)(YP + (size_t)yrow * 1024 + 16 * lane)); }
#pragma unroll
        for (int q = 0; q < 2; ++q) { const size_t row = (size_t)tl0 + q; float v[16];
            v[0] = bflo(xa[q].x); v[1] = bfhi(xa[q].x); v[2] = bflo(xa[q].y); v[3] = bfhi(xa[q].y); v[4] = bflo(xa[q].z); v[5] = bfhi(xa[q].z); v[6] = bflo(xa[q].w); v[7] = bfhi(xa[q].w);
            v[8] = bflo(xb[q].x); v[9] = bfhi(xb[q].x); v[10] = bflo(xb[q].y); v[11] = bfhi(xb[q].y); v[12] = bflo(xb[q].z); v[13] = bfhi(xb[q].z); v[14] = bflo(xb[q].w); v[15] = bfhi(xb[q].w);
#pragma unroll
            for (int j = 0; j < 16; ++j) v[j] *= DN_ALPHA;
            fma16_fp8(v, ys[q], 1.f / 16.f);
#pragma unroll
            for (int k = 0; k < 8; ++k) { const float wk = (k < 4 ? w03[q][k & 3] : w47[q][k & 3]) * (1.f / 16.f); fma16_fp8(v, yw[q][k], wk); }
            ln16(v, gb);
            st16_bf16(X + row * 1024 + 16 * lane, v); }
    }
}
__device__ __forceinline__ void phase_ln_rows(const bf16_t* src, const float* lng, const float* lnb, bf16_t* dstb, int gw, int NGW, int lane) {
    const GB16 gb = load_gb16(lng, lnb, lane);
    for (int t0 = 4 * gw; t0 < NTOK; t0 += 4 * NGW) { u32x4 a[4], b[4];
#pragma unroll
        for (int q = 0; q < 4; ++q) { a[q] = *(const u32x4*)(src + (size_t)(t0 + q) * 1024 + 16 * lane); b[q] = *(const u32x4*)(src + (size_t)(t0 + q) * 1024 + 16 * lane + 8); }
#pragma unroll
        for (int q = 0; q < 4; ++q) { float v[16];
            v[0] = bflo(a[q].x); v[1] = bfhi(a[q].x); v[2] = bflo(a[q].y); v[3] = bfhi(a[q].y); v[4] = bflo(a[q].z); v[5] = bfhi(a[q].z); v[6] = bflo(a[q].w); v[7] = bfhi(a[q].w);
            v[8] = bflo(b[q].x); v[9] = bfhi(b[q].x); v[10] = bflo(b[q].y); v[11] = bfhi(b[q].y); v[12] = bflo(b[q].z); v[13] = bfhi(b[q].z); v[14] = bflo(b[q].w); v[15] = bfhi(b[q].w);
            ln16(v, gb); st16_bf16(dstb + (size_t)(t0 + q) * 1024 + 16 * lane, v); } }
}

__device__ __forceinline__ void phase_gate(int tid, const bf16_t* Q, const float* KM, unsigned* acnt, int* alist, LAS unsigned char* lds, int G) {
    asm volatile("" : "+v"(tid)); const int  wave = __builtin_amdgcn_readfirstlane(tid >> 6), lane = tid & 63;
    LAS float* gl = (LAS float*)lds;
    LAS unsigned* hist = (LAS unsigned*)(lds + MISC_OFF + MS_TAB); LAS unsigned* basev = hist + 64;
    for (int u = blockIdx.x; u < 1024; u += G) {
        const int jb = u & 63, bh = u >> 6, b = bh >> 3, h = bh & 7;
        if (tid < 64) hist[tid] = 0u;
        __syncthreads();
        if (jb > 0) {
            f32x4 acc[2][4];
#pragma unroll
            for (int qb = 0; qb < 2; ++qb)
#pragma unroll
                for (int nb = 0; nb < 4; ++nb) acc[qb][nb] = (f32x4){0.f, 0.f, 0.f, 0.f};
            const size_t qrow0 = (size_t)b * SEQ + 256 * jb + 32 * wave;
#pragma unroll
            for (int ks = 0; ks < 4; ++ks) {
                bf16x8 qf[2];
#pragma unroll
                for (int qb = 0; qb < 2; ++qb) qf[qb] = *(const bf16x8*)(Q + (qrow0 + 16 * qb + (lane & 15)) * 1024 + h * 128 + ks * 32 + 8 * (lane >> 4));
#pragma unroll
                for (int nb = 0; nb < 4; ++nb) { const float* kp = KM + ((size_t)(bh * 64 + 16 * nb + (lane & 15))) * 128 + ks * 32 + 8 * (lane >> 4);
                    const f32x4 k0 = *(const f32x4*)kp * (1.f / 256.f), k1 = *(const f32x4*)(kp + 4) * (1.f / 256.f); const u32x4 kw = pack8(k0, k1);
                    const bf16x8 kf = *(const bf16x8*)&kw;
#pragma unroll
                    for (int qb = 0; qb < 2; ++qb) acc[qb][nb] = __builtin_amdgcn_mfma_f32_16x16x32_bf16(kf, qf[qb], acc[qb][nb], 0, 0, 0); }
            }
#pragma unroll
            for (int qb = 0; qb < 2; ++qb)
#pragma unroll
                for (int nb = 0; nb < 4; ++nb)
#pragma unroll
                    for (int r = 0; r < 4; ++r) gl[(32 * wave + 16 * qb + (lane & 15)) * 65 + 16 * nb + 4 * (lane >> 4) + r] = acc[qb][nb][r];
        }
        __syncthreads();
        int sel0 = 0, sel1 = 0, sel2 = 0, sp0 = 0, sp1 = 0, sp2 = 0; const int nsel = jb < 3 ? jb : 3;
        if (tid < 256 && jb > 0) {
            const float NEG = -__builtin_inff(); float v0 = NEG, v1 = NEG, v2 = NEG; int i0 = 0, i1 = 1, i2 = 2;
            const LAS float* gp = gl + tid * 65;
#pragma unroll 1
            for (int n0 = 0; n0 < jb; n0 += 8) { float xs[8];
#pragma unroll
                for (int j = 0; j < 8; ++j) xs[j] = gp[n0 + j];
#pragma unroll
                for (int j = 0; j < 8; ++j) { const int n = n0 + j; const float x = n < jb ? xs[j] : NEG;
                    const bool g0 = x > v0, g1 = x > v1, g2 = x > v2;
                    v2 = g1 ? v1 : (g2 ? x : v2); i2 = g1 ? i1 : (g2 ? n : i2);
                    v1 = g0 ? v0 : (g1 ? x : v1); i1 = g0 ? i0 : (g1 ? n : i1);
                    v0 = g0 ? x : v0; i0 = g0 ? n : i0; } }
            sel0 = i0; sel1 = i1; sel2 = i2;
            if (nsel > 0) sp0 = (int)__hip_atomic_fetch_add((LAS unsigned*)&hist[sel0], 1u, __ATOMIC_RELAXED, __HIP_MEMORY_SCOPE_WORKGROUP);
            if (nsel > 1) sp1 = (int)__hip_atomic_fetch_add((LAS unsigned*)&hist[sel1], 1u, __ATOMIC_RELAXED, __HIP_MEMORY_SCOPE_WORKGROUP);
            if (nsel > 2) sp2 = (int)__hip_atomic_fetch_add((LAS unsigned*)&hist[sel2], 1u, __ATOMIC_RELAXED, __HIP_MEMORY_SCOPE_WORKGROUP);
        }
        __syncthreads();
        if (tid < 64) { const unsigned c = hist[tid]; basev[tid] = c ? __hip_atomic_fetch_add(acnt + bh * 64 + tid, c, __ATOMIC_RELAXED, __HIP_MEMORY_SCOPE_AGENT) : 0u; }
        __syncthreads();
        if (tid < 256 && jb > 0) { const int ql = 256 * jb + tid;
            if (nsel > 0) alist[(size_t)(bh * 64 + sel0) * 16384 + basev[sel0] + sp0] = (ql << 2) | 0;
            if (nsel > 1) alist[(size_t)(bh * 64 + sel1) * 16384 + basev[sel1] + sp1] = (ql << 2) | 1;
            if (nsel > 2) alist[(size_t)(bh * 64 + sel2) * 16384 + basev[sel2] + sp2] = (ql << 2) | 2; }
        __syncthreads();
    }
}

namespace at {
constexpr int KVBLK = 64, NW = 8, QBLK = 32;
constexpr int SHM_V = KVBLK * 128 * 2, SHM_K = KVBLK * 128 * 2;
constexpr int LDK = 1024;
constexpr float THR = 8.f, C = 1.4426950408889634f;
#define AT_KSWZ(row, colB) ((row) * 256 + ((colB) ^ (((row) & 7) << 4)))
#define AT_SBAR() __builtin_amdgcn_sched_barrier(0)
__device__ __forceinline__ int crow(int r, int hi) { return (r & 3) + 8 * (r >> 2) + 4 * hi; }
__device__ __forceinline__ void partialSM(f32x16& p0, f32x16& p1, float& m_reg, float& mn, float& alpha, int kbase, int qlim, int hi) {
#pragma unroll
    for (int r = 0; r < 16; ++r) { const int key = kbase + crow(r, hi); if (key > qlim) p0[r] = -1e30f; if (key + 32 > qlim) p1[r] = -1e30f; }
    float pmax = p0[0];
#pragma unroll
    for (int r = 1; r < 16; ++r) pmax = fmaxf(pmax, p0[r]);
#pragma unroll
    for (int r = 0; r < 16; ++r) pmax = fmaxf(pmax, p1[r]);
    { auto rr = __builtin_amdgcn_permlane32_swap(__float_as_uint(pmax), __float_as_uint(pmax), false, false);
      pmax = fmaxf(__uint_as_float(rr[0]), __uint_as_float(rr[1])); }
    if (__builtin_expect(__all(pmax - m_reg <= THR), 1)) { mn = m_reg; alpha = 1.f; }
    else { mn = fmaxf(m_reg, pmax); alpha = __builtin_amdgcn_exp2f((m_reg - mn) * C); m_reg = mn; }
    const float mnC = -mn * C;
#pragma unroll
    for (int r = 0; r < 16; ++r) p0[r] = fmaf(p0[r], C, mnC);
#pragma unroll
    for (int r = 0; r < 16; ++r) p1[r] = fmaf(p1[r], C, mnC);
#pragma unroll
    for (int r = 0; r < 16; ++r) p0[r] = __builtin_amdgcn_exp2f(p0[r]);
}
__device__ __forceinline__ void finishSM(f32x16& p0, f32x16& p1, float alpha, float& l_reg, bf16x8& pa0, bf16x8& pa1, bf16x8& pa2, bf16x8& pa3) {
#pragma unroll
    for (int r = 0; r < 16; ++r) p1[r] = __builtin_amdgcn_exp2f(p1[r]);
    float ps = 0;
#pragma unroll
    for (int r = 0; r < 16; ++r) ps += p0[r];
#pragma unroll
    for (int r = 0; r < 16; ++r) ps += p1[r];
    { auto rr = __builtin_amdgcn_permlane32_swap(__float_as_uint(ps), __float_as_uint(ps), false, false);
      ps = __uint_as_float(rr[0]) + __uint_as_float(rr[1]); }
    l_reg = l_reg * alpha + ps;
#define AT_PK4(P, BASE, OUT) do { unsigned a0 = cvt_pk_bf16(P[BASE + 0], P[BASE + 1]), a1 = cvt_pk_bf16(P[BASE + 2], P[BASE + 3]);   \
    unsigned b0 = cvt_pk_bf16(P[BASE + 4], P[BASE + 5]), b1 = cvt_pk_bf16(P[BASE + 6], P[BASE + 7]);                              \
    auto r0 = __builtin_amdgcn_permlane32_swap(a0, b0, false, false); auto r1 = __builtin_amdgcn_permlane32_swap(a1, b1, false, false); \
    u32x4 w = {r0[0], r1[0], r0[1], r1[1]}; OUT = *reinterpret_cast<bf16x8*>(&w); } while (0)
    AT_PK4(p0, 0, pa0); AT_PK4(p0, 8, pa1); AT_PK4(p1, 0, pa2); AT_PK4(p1, 8, pa3);
#undef AT_PK4
}
__device__ __forceinline__ void qkt(f32x16& p0, f32x16& p1, const LAS char* Ks, const bf16x8* qr, int r32, int hi) {
    p0 = f32x16{}; p1 = f32x16{};
#pragma unroll
    for (int d0 = 0; d0 < 8; ++d0) { const int cb = (d0 * 16 + hi * 8) * 2;
        const bf16x8 b0 = *(const LAS bf16x8*)(Ks + AT_KSWZ(r32, cb));
        const bf16x8 b1 = *(const LAS bf16x8*)(Ks + AT_KSWZ(32 + r32, cb));
        p0 = __builtin_amdgcn_mfma_f32_32x32x16_bf16(b0, qr[d0], p0, 0, 0, 0);
        p1 = __builtin_amdgcn_mfma_f32_32x32x16_bf16(b1, qr[d0], p1, 0, 0, 0); }
}
__device__ __forceinline__ int v_st(int k, int c) { const int kk = (k & ~0xC) | ((k & 4) << 1) | ((k & 8) >> 1); return ((kk >> 3) * 4 + (c >> 5)) * 512 + ((kk & 7) * 32 + (c & 31)) * 2; }
__device__ __forceinline__ int v_rd_base(int lane) { return ((lane & 3) << 3) | (((lane >> 2) & 3) << 6) | (((lane >> 4) & 1) << 5) | (((lane >> 5) & 1) << 8); }
constexpr int v_rd_off(int d0, int ks, int half) { return d0 * 512 + ks * 4096 + half * 2048; }
template <int OFF> __device__ __forceinline__ s16x4 tr_read(int vb) {
    s16x4 r; asm volatile("ds_read_b64_tr_b16 %0, %1 offset:%2" : "=&v"(r) : "v"(vb), "i"(OFF) : "memory"); return r;
}
template <int D0> __device__ __forceinline__ void pv_one(f32x16& od, int vb, bf16x8 pa0, bf16x8 pa1, bf16x8 pa2, bf16x8 pa3) {
    const s16x4 l0 = tr_read<v_rd_off(D0, 0, 0)>(vb), h0 = tr_read<v_rd_off(D0, 0, 1)>(vb), l1 = tr_read<v_rd_off(D0, 1, 0)>(vb), h1 = tr_read<v_rd_off(D0, 1, 1)>(vb);
    const s16x4 l2 = tr_read<v_rd_off(D0, 2, 0)>(vb), h2 = tr_read<v_rd_off(D0, 2, 1)>(vb), l3 = tr_read<v_rd_off(D0, 3, 0)>(vb), h3 = tr_read<v_rd_off(D0, 3, 1)>(vb);
    asm volatile("s_waitcnt lgkmcnt(0)" ::: "memory"); AT_SBAR();
#define AT_PK(L, H) (bf16x8){L[0], L[1], L[2], L[3], H[0], H[1], H[2], H[3]}
    od = __builtin_amdgcn_mfma_f32_32x32x16_bf16(pa0, AT_PK(l0, h0), od, 0, 0, 0);
    od = __builtin_amdgcn_mfma_f32_32x32x16_bf16(pa1, AT_PK(l1, h1), od, 0, 0, 0);
    od = __builtin_amdgcn_mfma_f32_32x32x16_bf16(pa2, AT_PK(l2, h2), od, 0, 0, 0);
    od = __builtin_amdgcn_mfma_f32_32x32x16_bf16(pa3, AT_PK(l3, h3), od, 0, 0, 0);
#undef AT_PK
}
__device__ __forceinline__ void pv_d0(f32x16* o, int vb, bf16x8 pa0, bf16x8 pa1, bf16x8 pa2, bf16x8 pa3) {
    pv_one<0>(o[0], vb, pa0, pa1, pa2, pa3); pv_one<1>(o[1], vb, pa0, pa1, pa2, pa3); pv_one<2>(o[2], vb, pa0, pa1, pa2, pa3); pv_one<3>(o[3], vb, pa0, pa1, pa2, pa3);
}
__device__ __forceinline__ void attn_unit(int tid, const bf16_t* Qw, const bf16_t* Kh, const bf16_t* Vh, int qlim, LAS char* lds, f32x16 (&o)[4], float& m_out, float& l_out) {
    asm volatile("" : "+v"(tid)); const int  wid = tid >> 6, lane = tid & 63, r32 = lane & 31, hi = lane >> 5;
    LAS char* V_lds = lds; LAS char* K_lds = lds + 2 * SHM_V;
    LAS float* wsf = (LAS float*)(lds + 2 * SHM_V + 2 * SHM_K) + wid * 64; LAS float* al_l = wsf + 32;
    float m_reg = -1e30f, l_reg = 0;
#pragma unroll
    for (int d = 0; d < 4; ++d) o[d] = f32x16{};
    bf16x8 qr[8];
#pragma unroll
    for (int d0 = 0; d0 < 8; ++d0) qr[d0] = *(const bf16x8*)(Qw + d0 * 16);
    const int sr = tid >> 4, sc = (tid & 15) * 8, vst0 = v_st(sr, sc), vst1 = v_st(32 + sr, sc);
    const int vb0 = (int)(uintptr_t)V_lds + v_rd_base(lane);
    bf16x8 vsE0, vsE1, ksE0, ksE1, vsO0, vsO1, ksO0, ksO1;
#define AT_SLOAD(S, k0) do { vs##S##0 = *(const bf16x8*)(Vh + (size_t)((k0) + sr) * LDK + sc); vs##S##1 = *(const bf16x8*)(Vh + (size_t)((k0) + 32 + sr) * LDK + sc); \
    ks##S##0 = *(const bf16x8*)(Kh + (size_t)((k0) + sr) * LDK + sc); ks##S##1 = *(const bf16x8*)(Kh + (size_t)((k0) + 32 + sr) * LDK + sc); } while (0)
#define AT_SWRITE(b, S) do { *(LAS bf16x8*)(V_lds + (b) * SHM_V + vst0) = vs##S##0; *(LAS bf16x8*)(V_lds + (b) * SHM_V + vst1) = vs##S##1; const int kc = sc * 2; \
    *(LAS bf16x8*)(K_lds + (b) * SHM_K + AT_KSWZ(sr, kc)) = ks##S##0; *(LAS bf16x8*)(K_lds + (b) * SHM_K + AT_KSWZ(32 + sr, kc)) = ks##S##1; } while (0)
#define AT_SWAIT() asm volatile("s_waitcnt vmcnt(4)" ::: "memory")
#define AT_RESC(a) do { if (__any((a) < 1.f)) { if (hi == 0) al_l[r32] = (a); asm volatile("s_waitcnt lgkmcnt(0)" ::: "memory"); \
    _Pragma("unroll") for (int d = 0; d < 4; ++d) _Pragma("unroll") for (int r = 0; r < 16; ++r) o[d][r] *= al_l[crow(r, hi)]; } } while (0)
    f32x16 pA0, pA1, pB0, pB1; float mnA, mnB, alA, alB; bf16x8 pa0, pa1, pa2, pa3;
    AT_SLOAD(E, 0); asm volatile("s_waitcnt vmcnt(0)" ::: "memory"); AT_SWRITE(0, E); __syncthreads();
    qkt(pA0, pA1, K_lds, qr, r32, hi); partialSM(pA0, pA1, m_reg, mnA, alA, 0, qlim, hi);
    AT_SLOAD(O, KVBLK); AT_SLOAD(E, 2 * KVBLK);
    AT_SWAIT(); AT_SWRITE(1, O); __syncthreads();
    {
        AT_SBAR(); qkt(pB0, pB1, K_lds + SHM_K, qr, r32, hi);
        finishSM(pA0, pA1, alA, l_reg, pa0, pa1, pa2, pa3); AT_SBAR();
        AT_SLOAD(O, 3 * KVBLK); AT_SBAR();
        pv_d0(o, vb0, pa0, pa1, pa2, pa3); partialSM(pB0, pB1, m_reg, mnB, alB, 64, qlim, hi);
        __syncthreads(); AT_SWAIT(); AT_SWRITE(0, E);
        AT_RESC(alB); __syncthreads();
        AT_SBAR(); qkt(pA0, pA1, K_lds, qr, r32, hi);
        finishSM(pB0, pB1, alB, l_reg, pa0, pa1, pa2, pa3); AT_SBAR();
        pv_d0(o, vb0 + SHM_V, pa0, pa1, pa2, pa3); partialSM(pA0, pA1, m_reg, mnA, alA, 128, qlim, hi);
        __syncthreads(); asm volatile("s_waitcnt vmcnt(0)" ::: "memory"); AT_SWRITE(1, O);
        AT_RESC(alA); __syncthreads();
    }
    AT_SBAR(); qkt(pB0, pB1, K_lds + SHM_K, qr, r32, hi);
    finishSM(pA0, pA1, alA, l_reg, pa0, pa1, pa2, pa3); AT_SBAR();
    pv_d0(o, vb0, pa0, pa1, pa2, pa3); partialSM(pB0, pB1, m_reg, mnB, alB, 192, qlim, hi);
    __syncthreads(); AT_RESC(alB);
    finishSM(pB0, pB1, alB, l_reg, pa0, pa1, pa2, pa3); AT_SBAR();
    pv_d0(o, vb0 + SHM_V, pa0, pa1, pa2, pa3);
    m_out = m_reg; l_out = l_reg;
#undef AT_SLOAD
#undef AT_SWRITE
#undef AT_SWAIT
#undef AT_RESC
}

__device__ __forceinline__ void stage_block(int tid, const bf16_t* Kh, const bf16_t* Vh, LAS char* lds) {
    asm volatile("" : "+v"(tid));
    const int sr = tid >> 4, sc = (tid & 15) * 8, vst0 = v_st(sr, sc), vst1 = v_st(32 + sr, sc), kc = sc * 2;
    LAS char* V_lds = lds; LAS char* K_lds = lds + 65536;
#pragma unroll
    for (int hf = 0; hf < 2; ++hf) {
        bf16x8 v0[2], v1[2], k0[2], k1[2];
#pragma unroll
        for (int jj = 0; jj < 2; ++jj) { const int kb = 64 * (2 * hf + jj);
            v0[jj] = __builtin_nontemporal_load((const bf16x8*)(Vh + (size_t)(kb + sr) * LDK + sc)); v1[jj] = __builtin_nontemporal_load((const bf16x8*)(Vh + (size_t)(kb + 32 + sr) * LDK + sc));
            k0[jj] = __builtin_nontemporal_load((const bf16x8*)(Kh + (size_t)(kb + sr) * LDK + sc)); k1[jj] = __builtin_nontemporal_load((const bf16x8*)(Kh + (size_t)(kb + 32 + sr) * LDK + sc)); }
#pragma unroll
        for (int jj = 0; jj < 2; ++jj) { const int jt = 2 * hf + jj;
            *(LAS bf16x8*)(V_lds + jt * SHM_V + vst0) = v0[jj]; *(LAS bf16x8*)(V_lds + jt * SHM_V + vst1) = v1[jj];
            *(LAS bf16x8*)(K_lds + jt * SHM_K + AT_KSWZ(sr, kc)) = k0[jj]; *(LAS bf16x8*)(K_lds + jt * SHM_K + AT_KSWZ(32 + sr, kc)) = k1[jj]; }
    }
}
__device__ __forceinline__ void attn_block_unit(int tid, const bf16x8 (&qr)[8], int qlim, int ntile_w, LAS char* lds, f32x16 (&o)[4], float& m_out, float& l_out) {
    asm volatile("" : "+v"(tid)); const int wid = tid >> 6, lane = tid & 63, r32 = lane & 31, hi = lane >> 5;
    LAS char* V_lds = lds; LAS char* K_lds = lds + 65536;
    LAS float* wsf = (LAS float*)(lds + 131072) + wid * 64; LAS float* al_l = wsf + 32;
    float m_reg = -1e30f, l_reg = 0;
#pragma unroll
    for (int d = 0; d < 4; ++d) o[d] = f32x16{};
    const int vb0 = (int)(uintptr_t)V_lds + v_rd_base(lane);
#pragma unroll
    for (int jt = 0; jt < 4; ++jt) {
        if (jt < ntile_w) {
            f32x16 p0, p1; float mn, al; bf16x8 pa0, pa1, pa2, pa3;
            qkt(p0, p1, K_lds + jt * SHM_K, qr, r32, hi);
            partialSM(p0, p1, m_reg, mn, al, 64 * jt, qlim, hi);
            if (__any(al < 1.f)) { if (hi == 0) al_l[r32] = al; asm volatile("s_waitcnt lgkmcnt(0)" ::: "memory");
#pragma unroll
                for (int d = 0; d < 4; ++d)
#pragma unroll
                    for (int r = 0; r < 16; ++r) o[d][r] *= al_l[crow(r, hi)]; }
            finishSM(p0, p1, al, l_reg, pa0, pa1, pa2, pa3); AT_SBAR();
            pv_d0(o, vb0 + jt * SHM_V, pa0, pa1, pa2, pa3);
        }
    }
    m_out = m_reg; l_out = l_reg;
}
}

__device__ __forceinline__ void phase_attn(int tid, const bf16_t* Q, const bf16_t* KB, const bf16_t* VB, unsigned* acnt, const int* alist, bf16_t* PART, float* ML, LAS unsigned char* lds, int G, int vcu) {
    asm volatile("" : "+v"(tid)); const int  wave = __builtin_amdgcn_readfirstlane(tid >> 6), lane = tid & 63, r32 = lane & 31, hi = lane >> 5;
    LAS int* ustart = (LAS int*)(lds + MISC_OFF + MS_TAB);
    LAS int* qtab = ustart + 1028;
    LAS int* dtab = qtab + 256;
    LAS int* wtot = dtab + 256;
    __syncthreads();
    {
        const int c0 = (int)__hip_atomic_load(acnt + 2 * tid, __ATOMIC_RELAXED, __HIP_MEMORY_SCOPE_AGENT), c1 = (int)__hip_atomic_load(acnt + 2 * tid + 1, __ATOMIC_RELAXED, __HIP_MEMORY_SCOPE_AGENT);
        const int t0 = 1 + ((c0 + 255) >> 8), t1 = 1 + ((c1 + 255) >> 8);
        LAS int* ps = qtab;
        ps[tid] = t0 + t1;
        __syncthreads();
        int pre = 0;
        for (int j = 0; j < lane; ++j) pre += ps[wave * 64 + j];
        if (lane == 63) wtot[wave] = pre + t0 + t1;
        __syncthreads();
        for (int w = 0; w < wave; ++w) pre += wtot[w];
        __syncthreads();
        ustart[2 * tid] = pre; ustart[2 * tid + 1] = pre + t0;
        if (tid == 511) ustart[1024] = pre + t0 + t1;
        __syncthreads();
    }
    const int total = ustart[1024];
    for (int u = vcu; u < total; u += G) {
        int lo = 0, hiu = 1024;
#pragma unroll 1
        while (hiu - lo > 1) { const int mid = (lo + hiu) >> 1; if (ustart[mid] <= u) lo = mid; else hiu = mid; }
        const int li = lo, t = u - ustart[li], n = li & 63, bh = li >> 6, b = bh >> 3, h = bh & 7;
        const int cnt = (int)__hip_atomic_load(acnt + li, __ATOMIC_RELAXED, __HIP_MEMORY_SCOPE_AGENT);
        if (tid < 256) {
            int qrow, dst;
            if (t == 0) { qrow = b * SEQ + 256 * n + tid; dst = (qrow * 8 + h) * 4 + 3; }
            else { const int idx = 256 * (t - 1) + tid;
                if (idx < cnt) { const int e = alist[(size_t)li * 16384 + idx]; qrow = b * SEQ + (e >> 2); dst = (qrow * 8 + h) * 4 + (e & 3); }
                else { qrow = b * SEQ; dst = -1; } }
            qtab[tid] = qrow; dtab[tid] = dst;
        }
        __syncthreads();
        const int R = wave * 32 + r32; const int qrow = qtab[R];
        const int qlim = (t == 0) ? R : (1 << 30);
        f32x16 o[4]; float m_r, l_r;
        at::attn_unit(tid, Q + (size_t)qrow * 1024 + h * 128 + hi * 8, KB + ((size_t)b * SEQ + 256 * n) * 1024 + h * 128, VB + ((size_t)b * SEQ + 256 * n) * 1024 + h * 128, qlim,
                      (LAS char*)lds, o, m_r, l_r);
        if (hi == 0) { const int d = dtab[R]; if (d >= 0) *(f32x2*)(ML + (size_t)d * 2) = (f32x2){m_r, l_r}; }
#pragma unroll
        for (int r = 0; r < 16; ++r) { const int d = dtab[wave * 32 + at::crow(r, hi)];
            if (d >= 0) {
#pragma unroll
                for (int d0 = 0; d0 < 4; ++d0) PART[(size_t)d * 128 + d0 * 32 + r32] = (bf16_t)(cvt_pk_bf16(o[d0][r], 0.f) & 0xffffu); } }
        __syncthreads();
    }
}
__device__ __forceinline__ void phase_attn2(int tid, const bf16_t* Q, const bf16_t* KB, const bf16_t* VB, unsigned* acnt, const int* alist, bf16_t* PART, float* ML, unsigned* qhead, LAS unsigned char* lds) {
    asm volatile("" : "+v"(tid)); const int wave = __builtin_amdgcn_readfirstlane(tid >> 6), lane = tid & 63, r32 = lane & 31, hi = lane >> 5;
    LAS int* qtab = (LAS int*)(lds + MISC_OFF + MS_TAB);
    LAS int* dtab = qtab + 256;
    LAS int* bc = dtab + 256;
    LAS int* cnts = (LAS int*)(lds + 133120);
    cnts[2 * tid] = (int)__hip_atomic_load(acnt + 2 * tid, __ATOMIC_RELAXED, __HIP_MEMORY_SCOPE_AGENT); cnts[2 * tid + 1] = (int)__hip_atomic_load(acnt + 2 * tid + 1, __ATOMIC_RELAXED, __HIP_MEMORY_SCOPE_AGENT);
    unsigned nidx = 0u;
    if (tid == 0) nidx = __hip_atomic_fetch_add(qhead, 1u, __ATOMIC_RELAXED, __HIP_MEMORY_SCOPE_AGENT);
    for (;;) {
        __syncthreads();
        if (tid == 0) { const unsigned idx = nidx; int c = 0;
            if (idx < 1024u) { c = cnts[(idx & 15u) * 64u + (idx >> 4)]; nidx = __hip_atomic_fetch_add(qhead, 1u, __ATOMIC_RELAXED, __HIP_MEMORY_SCOPE_AGENT); }
            bc[0] = (int)idx; bc[1] = c; }
        __syncthreads();
        const int idx = bc[0]; if (idx >= 1024) break;
        const int cnt = bc[1], n = idx >> 4, bh = idx & 15, b = bh >> 3, h = bh & 7, li = bh * 64 + n;
        const int T = 1 + ((cnt + 255) >> 8);
        at::stage_block(tid, KB + ((size_t)b * SEQ + 256 * n) * 1024 + h * 128, VB + ((size_t)b * SEQ + 256 * n) * 1024 + h * 128, (LAS char*)lds);
        const int R = wave * 32 + r32;
        LAS int* dloc = dtab + wave * 32;
        const bf16_t* Qh = Q + h * 128 + hi * 8;
        int ecur = 0, enx = 0;
        if (T > 1) enx = alist[(size_t)li * 16384 + (R < cnt ? R : 0)];
        bf16x8 qr[8];
        {   const bf16_t* Qw = Qh + (size_t)(b * SEQ + 256 * n + R) * 1024;
#pragma unroll
            for (int d0 = 0; d0 < 8; ++d0) qr[d0] = *(const bf16x8*)(Qw + d0 * 16); }
        __syncthreads();
#pragma unroll 1
        for (int t = 0; t < T; ++t) {
            int qrow, dst;
            if (t == 0) { qrow = b * SEQ + 256 * n + R; dst = (qrow * 8 + h) * 4 + 3; }
            else { const bool ok = 256 * (t - 1) + R < cnt; qrow = b * SEQ + (ok ? (ecur >> 2) : 0); dst = ok ? ((qrow * 8 + h) * 4 + (ecur & 3)) : -1; }
            bf16x8 qn[8]; int enx2 = 0;
            if (t + 1 < T) { const bool ok1 = 256 * t + R < cnt; const bf16_t* Qw = Qh + (size_t)(b * SEQ + (ok1 ? (enx >> 2) : 0)) * 1024;
#pragma unroll
                for (int d0 = 0; d0 < 8; ++d0) qn[d0] = *(const bf16x8*)(Qw + d0 * 16);
            } else {
#pragma unroll
                for (int d0 = 0; d0 < 8; ++d0) qn[d0] = qr[d0]; }
            if (t + 2 < T) { const int i2 = 256 * (t + 1) + R; enx2 = alist[(size_t)li * 16384 + (i2 < cnt ? i2 : 0)]; }
            if (hi == 0) dloc[r32] = dst;
            const int qlim = (t == 0) ? R : (1 << 30); const int ntw = (t == 0) ? (((wave * 32 + 31) >> 6) + 1) : 4;
            f32x16 o[4]; float m_r, l_r;
            at::attn_block_unit(tid, qr, qlim, ntw, (LAS char*)lds, o, m_r, l_r);
#pragma unroll
            for (int d0 = 0; d0 < 8; ++d0) qr[d0] = qn[d0];
            ecur = enx; enx = enx2;
            if (hi == 0 && dst >= 0) *(f32x2*)(ML + (size_t)dst * 2) = (f32x2){m_r, l_r};
            asm volatile("s_waitcnt lgkmcnt(0)" ::: "memory");
#pragma unroll
            for (int r = 0; r < 16; ++r) { const int d = dloc[at::crow(r, hi)];
                if (d >= 0) {
#pragma unroll
                    for (int d0 = 0; d0 < 4; ++d0) PART[(size_t)d * 128 + d0 * 32 + r32] = (bf16_t)(cvt_pk_bf16(o[d0][r], 0.f) & 0xffffu); } }
            asm volatile("s_waitcnt lgkmcnt(0)" ::: "memory");
        }
    }
}
__device__ __forceinline__ void phase_attn_combine(const bf16_t* PART, const float* ML, bf16_t* ATT, int gw, int NGW, int lane) {
    for (int t = gw; t < NTOK; t += NGW) {
        const int own = (t & (SEQ - 1)) >> 8, nsel = own < 3 ? own : 3, head = lane >> 3, c16 = (lane & 7) * 16;
        const size_t p4 = ((size_t)t * 8 + head) * 4;
        f32x2 ml[4]; u32x4 pa[4], pb[4];
#pragma unroll
        for (int s = 0; s < 4; ++s) { ml[s] = *(const f32x2*)(ML + (p4 + s) * 2); pa[s] = __builtin_nontemporal_load((const u32x4*)(PART + (p4 + s) * 128 + c16)); pb[s] = __builtin_nontemporal_load((const u32x4*)(PART + (p4 + s) * 128 + c16 + 8)); }
        float ms[4], ls[4]; float M = -1e30f;
#pragma unroll
        for (int s = 0; s < 4; ++s) { const bool valid = (s == 3) || (s < nsel); ms[s] = valid ? ml[s].x : -1e30f; ls[s] = valid ? ml[s].y : 0.f; M = fmaxf(M, ms[s]); }
        float acc[16];
#pragma unroll
        for (int j = 0; j < 16; ++j) acc[j] = 0.f;
        float L = 0.f;
#pragma unroll
        for (int s = 0; s < 4; ++s) { const bool valid = (s == 3) || (s < nsel);
            const float w = valid ? __builtin_amdgcn_exp2f((ms[s] - M) * 1.4426950408889634f) : 0.f; L += w * ls[s];
            const u32x4 a = valid ? pa[s] : (u32x4){0u, 0u, 0u, 0u}, bq = valid ? pb[s] : (u32x4){0u, 0u, 0u, 0u};
            acc[0] += w * bflo(a.x); acc[1] += w * bfhi(a.x); acc[2] += w * bflo(a.y); acc[3] += w * bfhi(a.y); acc[4] += w * bflo(a.z); acc[5] += w * bfhi(a.z); acc[6] += w * bflo(a.w); acc[7] += w * bfhi(a.w);
            acc[8] += w * bflo(bq.x); acc[9] += w * bfhi(bq.x); acc[10] += w * bflo(bq.y); acc[11] += w * bfhi(bq.y); acc[12] += w * bflo(bq.z); acc[13] += w * bfhi(bq.z); acc[14] += w * bflo(bq.w); acc[15] += w * bfhi(bq.w); }
        const float inv = 1.0f / L;
        u32x4 o0, o1;
        o0.x = cvt_pk_bf16(acc[0] * inv, acc[1] * inv); o0.y = cvt_pk_bf16(acc[2] * inv, acc[3] * inv); o0.z = cvt_pk_bf16(acc[4] * inv, acc[5] * inv); o0.w = cvt_pk_bf16(acc[6] * inv, acc[7] * inv);
        o1.x = cvt_pk_bf16(acc[8] * inv, acc[9] * inv); o1.y = cvt_pk_bf16(acc[10] * inv, acc[11] * inv); o1.z = cvt_pk_bf16(acc[12] * inv, acc[13] * inv); o1.w = cvt_pk_bf16(acc[14] * inv, acc[15] * inv);
        *(u32x4*)(ATT + (size_t)t * 1024 + head * 128 + c16) = o0; *(u32x4*)(ATT + (size_t)t * 1024 + head * 128 + c16 + 8) = o1;
    }
}

struct Args { const float* in[29]; float* out; unsigned char* ws; int ph_lo, ph_hi; float inv_freq[16]; };

__global__ void __launch_bounds__(NTHR, 2) mk_fwd(Args a) {
    extern __shared__ __attribute__((aligned(16))) unsigned char lds_raw[];
    LAS unsigned char* lds = (LAS unsigned char*)lds_raw;
    const int G = gridDim.x, NGW = G * NWAVES;
    const size_t gthreads = (size_t)G * NTHR;
    const int vcu = (G % 8 == 0) ? (int)(blockIdx.x % 8) * (G / 8) + (int)(blockIdx.x / 8) : (int)blockIdx.x;
    const int wave0 = __builtin_amdgcn_readfirstlane(threadIdx.x >> 6);
    if (threadIdx.x < 16) ((LAS unsigned*)(lds + MISC_OFF))[threadIdx.x] = 0u;
    __syncthreads();
    typedef const Args __attribute__((address_space(4))) * ArgsP;
    const ArgsP ap0 = (ArgsP)__builtin_amdgcn_kernarg_segment_ptr();
#define ctl ((unsigned*)(ws + WS_CTL))
#define KM ((float*)(ws + WS_KM))
#define ROPE ((float*)(ws + WS_ROPE))
#define wl (ws + WS_WL + (size_t)(l & 1) * (WS_WL2 - WS_WL))
#define w_mix0 ((bf16_t*)(wl + WL_MIX))
#define gates_t ((bf16_t*)(wl + WL_MIX + 4 * MiB))
#define w_out_t ((bf16_t*)(wl + WL_MIX + 5 * MiB))
#define wq_t ((bf16_t*)(wl + WL_MIX))
#define wo_t ((bf16_t*)(wl + WL_MIX + 2 * MiB))
#define wkv_t ((bf16_t*)(wl + WL_MIX + 4 * MiB))
#define router_t ((bf16_t*)(wl + WL_ROUTER))
#define shgu_t ((bf16_t*)(wl + WL_SHGU))
#define shd_t ((bf16_t*)(wl + WL_SHD))
#define pleg_t ((bf16_t*)(wl + WL_PLEG))
#define plew_t ((bf16_t*)(wl + WL_PLEW))
#define egu_t ((bf16_t*)(wl + WL_EGU))
#define ed_t ((bf16_t*)(wl + WL_ED))
#define PB ((bf16_t*)(ws + WS_PB))
#define SB0 ((bf16_t*)(ws + WS_SB0))
#define SB1 ((bf16_t*)(ws + WS_SB1))
#define KBUF ((bf16_t*)(ws + WS_KB))
#define VBUF ((bf16_t*)(ws + WS_VB))
#define PW ((bf16_t*)(ws + WS_PW))
#define HDN ((bf16_t*)(ws + WS_HDN))
#define HSH ((bf16_t*)(ws + WS_HSH))
#define YSH ((unsigned char*)(ws + WS_YSH))
#define YP ((unsigned char*)(ws + WS_YP))
#define ELIST ((int*)(ws + WS_ELIST))
#define WPAIR ((float*)(ws + WS_WPAIR))
#define PPOS ((int*)(ws + WS_PPOS))
#define IDL ((int*)(ws + WS_IDL))
#define XBR ((bf16_t*)(ws + WS_XBR))
#define YG ((bf16_t*)(ws + WS_Y))
#define XC ((bf16_t*)(ws + WS_XC))
#define LAb ((bf16_t*)(ws + WS_LA))
#define Ub ((bf16_t*)(ws + WS_U))
#define HY ((bf16_t*)(ws + WS_HY))
#define CH ((float*)(ws + WS_CH))
#define CL (CH + 512 * 1024)
#define CIN (CH + 2 * 512 * 1024)
#define SP8 (CH + 3 * 512 * 1024)
#define QB ((bf16_t*)(ws + WS_Q))
#define ATT ((bf16_t*)(ws + WS_ATT))
#define PART ((bf16_t*)(ws + WS_PART))
#define ML ((float*)(ws + WS_ML))
#define ALIST ((int*)(ws + WS_ALIST))
#define in_x (IN(0))
#define IN(k) ((const float*)ap->in[k])
#define ln_g (IN(2) + (size_t)l * 2 * DM)
#define ln_b (IN(3) + (size_t)l * 2 * DM)

#if MK_MULTI
#define GRID_BAR() do { } while (0)
#else
    XcdBarrier bar; { unsigned char* ws = a.ws; bar = xcd_barrier_post(ctl + CW_BAR, (volatile LAS unsigned*)(lds + MISC_OFF + MS_BAR)); }
#define GRID_BAR() xcd_barrier(bar, wave0 == 0 && lane_id() == 0)
#endif
    int pid = 0;
#ifndef PH_MASK
#define PH_MASK 0xFFFFFFFFu
#endif
#ifndef DUP_MASK
#define DUP_MASK 0u
#endif
#define PHASE_BEGIN(k) if (((PH_MASK >> (k)) & 1u) && a.ph_lo <= pid && pid < a.ph_hi) { for (int rep_ = 0; rep_ < 1 + (int)((DUP_MASK >> (k)) & 1u); ++rep_) { ArgsP ap = ap0; asm volatile("" : "+s"(ap)); unsigned char* ws = ap->ws; int tid = wave0 * 64 + lane_id(); asm volatile("" : "+v"(tid)); const int lane = tid & 63, wave = wave0, gw = blockIdx.x * NWAVES + wave; const size_t gtid = (size_t)blockIdx.x * NTHR + tid; (void)lane; (void)gw; (void)gtid;
#define PHASE_END GRID_BAR(); } } ++pid;

#define wlL(LL) (ws + WS_WL + (size_t)((LL) & 1) * (WS_WL2 - WS_WL))
#define w_mix0_L ((bf16_t*)(wlL(LL) + WL_MIX))
#define gates_t_L ((bf16_t*)(wlL(LL) + WL_MIX + 4 * MiB))
#define w_out_t_L ((bf16_t*)(wlL(LL) + WL_MIX + 5 * MiB))
#define wq_t_L ((bf16_t*)(wlL(LL) + WL_MIX))
#define wo_t_L ((bf16_t*)(wlL(LL) + WL_MIX + 2 * MiB))
#define wkv_t_L ((bf16_t*)(wlL(LL) + WL_MIX + 4 * MiB))
#define router_t_L ((bf16_t*)(wlL(LL) + WL_ROUTER))
#define shgu_t_L ((bf16_t*)(wlL(LL) + WL_SHGU))
#define shd_t_L ((bf16_t*)(wlL(LL) + WL_SHD))
#define pleg_t_L ((bf16_t*)(wlL(LL) + WL_PLEG))
#define plew_t_L ((bf16_t*)(wlL(LL) + WL_PLEW))
#define egu_t_L ((bf16_t*)(wlL(LL) + WL_EGU))
#define ed_t_L ((bf16_t*)(wlL(LL) + WL_ED))
#define LP_BODY(LL) do { \
            LAS float* scr = (LAS float*)(lds + wave * 16384); \
            int base = 0; \
            if (LL < 2) { \
                conv_job(IN(4) + (size_t)LL * 1024 * 2048, w_mix0_L, 1024, 2048, 1, 0, 0, base, gw, NGW, scr, lane); \
                conv_job(IN(8) + (size_t)LL * 4 * 65536, gates_t_L, 256, 256, 4, 512 * 256, 1, base, gw, NGW, scr, lane); \
                conv_job(IN(10) + (size_t)LL * 4 * 65536, gates_t_L, 256, 256, 4, 512 * 256, 2, base, gw, NGW, scr, lane); \
                conv_job(IN(13) + (size_t)LL * 1024 * 1024, w_out_t_L, 1024, 1024, 1, 0, 0, base, gw, NGW, scr, lane); \
            } else { \
                conv_job(IN(17) + (size_t)(LL - 2) * 1024 * 1024, wq_t_L, 1024, 1024, 1, 0, 0, base, gw, NGW, scr, lane); \
                conv_job(IN(18) + (size_t)(LL - 2) * 1024 * 1024, wo_t_L, 1024, 1024, 1, 0, 0, base, gw, NGW, scr, lane); \
                if (LL == 2) conv_job(IN(16), wkv_t_L, 1024, 2048, 1, 0, 0, base, gw, NGW, scr, lane); \
            } \
            conv_job(IN(19) + (size_t)LL * 1024 * 64, router_t_L, 1024, 64, 1, 0, 0, base, gw, NGW, scr, lane); \
            conv_job(IN(24) + (size_t)LL * 1024 * 256, shgu_t_L, 1024, 256, 1, 0, 1, base, gw, NGW, scr, lane); \
            conv_job(IN(25) + (size_t)LL * 1024 * 256, shgu_t_L, 1024, 256, 1, 0, 2, base, gw, NGW, scr, lane); \
            conv_job(IN(26) + (size_t)LL * 256 * 1024, shd_t_L, 256, 1024, 1, 0, 0, base, gw, NGW, scr, lane); \
            conv_job(IN(28) + (size_t)LL * 1024 * 1024, pleg_t_L, 1024, 1024, 1, 0, 0, base, gw, NGW, scr, lane); \
            conv_job(IN(27) + (size_t)LL * 256 * 1024, plew_t_L, 256, 1024, 1, 0, 0, base, gw, NGW, scr, lane); \
            conv_job(IN(21) + (size_t)LL * 64 * 1024 * 256, egu_t_L, 1024, 256, 64, 512 * 1024, 1, base, gw, NGW, scr, lane); \
            conv_job(IN(22) + (size_t)LL * 64 * 1024 * 256, egu_t_L, 1024, 256, 64, 512 * 1024, 2, base, gw, NGW, scr, lane); \
            conv_job(IN(23) + (size_t)LL * 64 * 256 * 1024, ed_t_L, 256, 1024, 64, 1024 * 256, 0, base, gw, NGW, scr, lane); \
            cvt_f32_bf16(IN(1) + (size_t)LL * NTOK * PLE, PB, (size_t)NTOK * PLE / 8, gtid, gthreads); \
            if (LL == 0) { for (size_t i = gtid; i < (size_t)NTOK; i += gthreads) IDL[i] = (int)i * 8; } \
            if (LL < 2) { for (size_t i = gtid; i < 1024; i += gthreads) SP8[i] = -8.0f * log1pf(__expf(-IN(12)[(size_t)LL * 1024 + i])); } \
            if (LL == 0) { \
                cvt_f32_bf16(in_x, SB0, (size_t)NTOK * DM / 8, gtid, gthreads); \
                for (size_t i = gtid; i < (size_t)SEQ * 16; i += gthreads) { const int pos = (int)(i >> 4), fi = (int)(i & 15); \
                    const float ang = (float)pos * ap->inv_freq[fi]; const double rev = (double)ang * 0.15915494309189533577; const float fr_ = (float)(rev - floor(rev)); \
                    ROPE[i] = __builtin_amdgcn_cosf(fr_); ROPE[(size_t)SEQ * 16 + i] = __builtin_amdgcn_sinf(fr_); } \
            } \
        } while (0)
    { const int l = 0; (void)l;
        PHASE_BEGIN(0)
            { const int LL = 0; LP_BODY(LL); }
            __syncthreads();
        PHASE_END
    }
#pragma unroll 1
    for (int l = 0; l < DEPTH; ++l) {
        bool mixer_on = true;
        if (l < 2) {
#if EN_RGLRU
            PHASE_BEGIN(1)
                SchedStatic S{128, 8, G, (int)blockIdx.x, w_mix0, 1024, 0, 0}; EpiWin E{XBR, YG, IN(5) + (size_t)l * 2048};
                ge::gemm_phase<1024, 1024, 1024, 0, 3, false, false, true>(lds, tid, SB0, S, E);
            PHASE_END
            PHASE_BEGIN(2)
                phase_conv(XBR, XC, IN(6) + (size_t)l * 4 * 1024, IN(7) + (size_t)l * 1024, gw, NGW, lane);
            PHASE_END
            PHASE_BEGIN(3)
                SchedStatic S{128, 8, G, (int)blockIdx.x, gates_t, 256, 2, 512}; EpiGates E{XC, (unsigned char*)LAb, Ub, IN(9) + (size_t)l * 1024, IN(11) + (size_t)l * 1024, SP8};
                ge::gemm_phase<256, 1024, 256, 0, 1, false, false, true>(lds, tid, XC, S, E);
            PHASE_END
            PHASE_BEGIN(4)
                phase_scan1((const unsigned char*)LAb, Ub, SP8, CH, CL, gw, NGW, lane);
            PHASE_END
            PHASE_BEGIN(5)
                phase_scan_carry(CH, CL, CIN, tid, lds, G);
            PHASE_END
            PHASE_BEGIN(6)
                phase_scan2((const unsigned char*)LAb, Ub, YG, SP8, CIN, HY, gw, NGW, lane);
            PHASE_END
#else
            mixer_on = false;
#endif
        } else {
#if EN_MOBA
            if (l == 2) {
                PHASE_BEGIN(7)
                    phase_ln_rows(SB0, IN(14), IN(15), QB, gw, NGW, lane);
                PHASE_END
                PHASE_BEGIN(8)
                    SchedStatic S{128, 8, G, (int)blockIdx.x, wkv_t, 1024, 0, 0}; EpiKV E{KBUF, VBUF, ROPE, KM};
                    ge::gemm_phase<1024, 1024, 1024, 0, 4, false, false, true>(lds, tid, QB, S, E);
                PHASE_END
            }
            PHASE_BEGIN(9)
                SchedStatic S{128, 4, G, (int)blockIdx.x, wq_t, 1024, 0, 0}; EpiQ E{QB, ROPE};
                ge::gemm_phase<1024, 1024, 1024, 0, 4, false, false, true>(lds, tid, SB0, S, E);
            PHASE_END
            PHASE_BEGIN(10)
                phase_gate(tid, QB, KM, ctl + CW_ACNT + (l - 2) * 1024, ALIST, lds, G);
            PHASE_END
            PHASE_BEGIN(11)
                phase_attn2(tid, QB, KBUF, VBUF, ctl + CW_ACNT + (l - 2) * 1024, ALIST, PART, ML, ctl + CW_AQ + (l - 2) * 64, lds);
            PHASE_END
            PHASE_BEGIN(12)
                phase_attn_combine(PART, ML, ATT, gw, NGW, lane);
            PHASE_END
#else
            mixer_on = false;
#endif
        }
        PHASE_BEGIN(13)
            if (mixer_on) {
                SchedStatic S{128, 4, G, (int)blockIdx.x, (l < 2) ? w_out_t : wo_t, 1024, 0, 0}; EpiZ E{SB0, SB1};
                ge::gemm_phase<1024, 1024, 1024, 0, 3, false, false, true>(lds, tid, (l < 2) ? HY : ATT, S, E);
            } else {
                for (size_t i = gtid; i < (size_t)NTOK * DM / 4; i += gthreads) { const u32x2 xw = *(const u32x2*)(SB0 + i * 4); *(u32x2*)(SB1 + i * 4) = pack4((f32x4){bflo(xw.x), bfhi(xw.x), bflo(xw.y), bfhi(xw.y)} * DN_ALPHA); }
            }
        PHASE_END
        PHASE_BEGIN(14)
            phase_r1(tid, ln_g, ln_b, SB1, router_t, IN(20) + (size_t)l * 64, ctl + CW_ECNT + l * 128, ELIST, WPAIR, PPOS, lds, G);
        PHASE_END
        PHASE_BEGIN(15)
            { MoeTab T = moe_tables<true>(tid, ctl + CW_ECNT + l * 128, lds);
              SchedMoe1 S{T, G, vcu, ELIST, egu_t, shgu_t, IDL}; EpiMoe1 E{HDN, HSH};
              ge::gemm_phase<1024, 1024, 1024, 3, 1, true, false, true>(lds, tid, SB1, S, E); }
            {
              const int U = (((LAS int*)(lds + MISC_OFF + MS_TAB))[64] + 128) * 2, rem = U % G;
              const int Gp = rem ? G - rem : G, cp = rem ? vcu - rem : vcu;
              if (cp >= 0) { SchedStatic S{128, 4, Gp, cp, plew_t, 256, 0, 0}; EpiBf16 E{PW, 1024};
                ge::gemm_phase<256, 256, 256, 0, 3, false, false, true>(lds, tid, PB, S, E); } }
        PHASE_END
        PHASE_BEGIN(16)
            MoeTab T = moe_tables<true>(tid, ctl + CW_ECNT + l * 128, lds);
            SchedMoe2 S{T, G, vcu, ELIST, ed_t, shd_t}; EpiMoe2 E{YP, YSH};
            ge::gemm_phase<256, 256, 256, 0, 2, false, true, true>(lds, tid, HDN, S, E);
        PHASE_END
        PHASE_BEGIN(17)
            MoeTab T = moe_tables<false>(tid, ctl + CW_ECNT + l * 128, lds);
            phase_m4(ln_g + DM, ln_b + DM, SB1, YP, YSH, WPAIR, PPOS, T.sbase, gw, NGW, lane);
        PHASE_END
        PHASE_BEGIN(18)
            const int par = (int)(blockIdx.x & 1);
#pragma unroll 1
            for (int st = 0; st < 2; ++st) {
                if ((st ^ par) != 0) {
                    SchedStatic S{128, 4, G, (int)blockIdx.x, pleg_t, 1024, 0, 0}; EpiPle E{SB1, PW, (l == DEPTH - 1) ? (float*)ap->out : nullptr, SB0};
                    ge::gemm_phase<1024, 1024, 1024, 0, 3, false, false, true>(lds, tid, SB1, S, E);
                } else if (l + 1 < DEPTH) {
                    ArgsP ap = ap0; asm volatile("" : "+s"(ap)); unsigned char* ws = ap->ws; int tid = wave0 * 64 + lane_id(); asm volatile("" : "+v"(tid));
                    const int lane = tid & 63, wave = wave0, gw = blockIdx.x * NWAVES + wave; const size_t gtid = (size_t)blockIdx.x * NTHR + tid;
                    const int LL = l + 1; LP_BODY(LL); __syncthreads(); }
            }
        PHASE_END
    }
}

static int count_phases() {
    int n = 1;
    for (int l = 0; l < DEPTH; ++l) { if (l < 2) n += EN_RGLRU ? 6 : 0; else n += EN_MOBA ? ((l == 2 ? 2 : 0) + 4) : 0; n += 1 + 1 + 1 + 2 + 1; }
    return n;
}
extern "C" void kernel_launch(void* const* d_in, const int* in_sizes, int n_in, void* d_out, int out_size, void* d_ws, size_t ws_size, hipStream_t stream) {
    static int grid = 0;
    if (grid == 0) {
        if (n_in != 29 || out_size != NTOK * DM || ws_size < WS_END) { fprintf(stderr, "kernel_launch: unexpected shapes (n_in %d out %d ws %zu need %zu)\n", n_in, out_size, ws_size, (size_t)WS_END); grid = -1; return; }
        int dev = 0, cus = 0, per_cu = 0;
        if (hipGetDevice(&dev) != hipSuccess || hipDeviceGetAttribute(&cus, hipDeviceAttributeMultiprocessorCount, dev) != hipSuccess) { grid = -1; return; }
        if (hipFuncSetAttribute((const void*)mk_fwd, hipFuncAttributeMaxDynamicSharedMemorySize, LDS_BYTES) != hipSuccess) { fprintf(stderr, "kernel_launch: hipFuncSetAttribute failed\n"); grid = -1; return; }
        if (hipOccupancyMaxActiveBlocksPerMultiprocessor(&per_cu, (const void*)mk_fwd, NTHR, LDS_BYTES) != hipSuccess || per_cu < 1) { fprintf(stderr, "kernel_launch: occupancy query says %d\n", per_cu); (void)hipGetLastError(); grid = -1; return; }
        grid = cus;
    }
    if (grid < 0) return;
    (void)hipMemsetAsync((char*)d_ws + WS_CTL, 0, CTL_BYTES, stream);
    Args a{};
    for (int i = 0; i < 29; ++i) a.in[i] = (const float*)d_in[i];
    a.out = (float*)d_out; a.ws = (unsigned char*)d_ws;
    for (int i = 0; i < 16; ++i) a.inv_freq[i] = (float)pow(500000.0, -(double)(2 * i) / 32.0);
#if MK_MULTI
    const int np = count_phases();
    for (int p = 0; p < np; ++p) { a.ph_lo = p; a.ph_hi = p + 1; hipLaunchKernelGGL(mk_fwd, dim3(grid), dim3(NTHR), LDS_BYTES, stream, a); }
#else
    a.ph_lo = 0; a.ph_hi = 1 << 30;
    hipLaunchKernelGGL(mk_fwd, dim3(grid), dim3(NTHR), LDS_BYTES, stream, a);
#endif
    const hipError_t le = hipPeekAtLastError();
    if (le != hipSuccess) fprintf(stderr, "kernel_launch: launch failed: %s\n", hipGetErrorName(le));
}
```

```cpp
#include <hip/hip_runtime.h>
#include <cstdio>
#include <cstdint>
#include <cmath>

#ifndef MK_MULTI
#define MK_MULTI 0
#endif
#ifndef EN_RGLRU
#define EN_RGLRU 1
#endif
#ifndef EN_MOBA
#define EN_MOBA 1
#endif

#define LAS __attribute__((address_space(3)))
typedef unsigned short bf16_t;
typedef short bf16x8 __attribute__((ext_vector_type(8)));
typedef short s16x4 __attribute__((ext_vector_type(4)));
typedef float f32x4 __attribute__((ext_vector_type(4)));
typedef float f32x2 __attribute__((ext_vector_type(2)));
typedef float f32x16 __attribute__((ext_vector_type(16)));
typedef unsigned u32x4 __attribute__((ext_vector_type(4)));
typedef unsigned u32x2 __attribute__((ext_vector_type(2)));
typedef int i32x4 __attribute__((ext_vector_type(4)));

constexpr int NTOK = 32768, DM = 1024, SEQ = 16384, NBATCH = 2, DEPTH = 4;
constexpr int NEXP = 64, DEXP = 256, PLE = 256, NHEAD = 8, HD = 128, MBLK = 256, NBLK = 64;
constexpr float DN_ALPHA = 1.6817928305074290f;
constexpr float LN_EPS = 1e-5f;
constexpr int NWAVES = 8, NTHR = 512;

constexpr size_t MiB = (size_t)1 << 20;
constexpr size_t WS_CTL = 0, CTL_BYTES = 2 * MiB;
constexpr size_t WS_KM = 1 * MiB;
constexpr size_t WS_ROPE = 2 * MiB;
constexpr size_t WS_WL = 4 * MiB;
constexpr size_t WL_MIX = 0;
constexpr size_t WL_ROUTER = 8 * MiB, WL_SHGU = 8 * MiB + 512 * 1024, WL_SHD = 9 * MiB + 512 * 1024, WL_PLEG = 10 * MiB, WL_PLEW = 12 * MiB;
constexpr size_t WL_EGU = 13 * MiB, WL_ED = 77 * MiB;
constexpr size_t WS_WL2 = 132 * MiB;
constexpr size_t WS_PB = 116 * MiB;
constexpr size_t WS_XS = 132 * MiB;
constexpr size_t WS_SB0 = 260 * MiB, WS_SB1 = 324 * MiB;
constexpr size_t WS_KB = 388 * MiB, WS_VB = 452 * MiB;
constexpr size_t WS_PW = 516 * MiB;
constexpr size_t WS_TMP = 580 * MiB;
constexpr size_t WS_HDN = WS_TMP;
constexpr size_t WS_HSH = 757 * MiB;
constexpr size_t WS_YSH = 725 * MiB;
constexpr size_t WS_YP = 773 * MiB;
constexpr size_t WS_ELIST = 1045 * MiB;
constexpr size_t WS_WPAIR = 1053 * MiB;
constexpr size_t WS_PPOS = 1055 * MiB;
constexpr size_t WS_IDL = 1054 * MiB;
constexpr size_t WS_END = 1056 * MiB;
constexpr size_t WS_XBR = WS_TMP, WS_Y = WS_TMP + 64 * MiB, WS_XC = WS_TMP + 128 * MiB, WS_LA = WS_TMP + 192 * MiB, WS_U = WS_TMP + 256 * MiB, WS_HY = WS_TMP + 320 * MiB;
constexpr size_t WS_CH = WS_TMP + 384 * MiB;
constexpr size_t WS_Q = WS_TMP, WS_ATT = WS_TMP + 64 * MiB, WS_PART = WS_TMP + 128 * MiB  , WS_ML = WS_TMP + 384 * MiB  , WS_ALIST = WS_TMP + 392 * MiB  ;
constexpr int CW_BAR = 4096, CW_ECNT = 8192  , CW_ACNT = 9216  , CW_AQ = 11264  ;

constexpr int LDS_BYTES = 147456;
constexpr int MISC_OFF = 139264;
constexpr int MS_BAR = 0, MS_TAB = 64;

__device__ __forceinline__ unsigned cvt_pk_bf16(float lo, float hi) { unsigned r; asm volatile("v_cvt_pk_bf16_f32 %0, %1, %2" : "=v"(r) : "v"(lo), "v"(hi)); return r; }
__device__ __forceinline__ float bf2f(unsigned short b) { return __uint_as_float(((unsigned)b) << 16); }
__device__ __forceinline__ float bflo(unsigned w) { return __uint_as_float(w << 16); }
__device__ __forceinline__ float bfhi(unsigned w) { return __uint_as_float(w & 0xffff0000u); }
__device__ __forceinline__ float sigmoidf_(float x) { return __builtin_amdgcn_rcpf(1.0f + __expf(-x)); }
__device__ __forceinline__ float dpp_add(float v, int ctrl_is_unused);
#define DPP_ADD(v, CTRL) ((v) + __int_as_float(__builtin_amdgcn_update_dpp(0, __float_as_int(v), (CTRL), 0xF, 0xF, true)))
__device__ __forceinline__ float row_sum16(float v) { v = DPP_ADD(v, 0xB1); v = DPP_ADD(v, 0x4E); v = DPP_ADD(v, 0x141); v = DPP_ADD(v, 0x140); return v; }
__device__ __forceinline__ float wave_sum(float v) {
    v = row_sum16(v);
    const int iv = __float_as_int(v);
    return (__int_as_float(__builtin_amdgcn_readlane(iv, 0)) + __int_as_float(__builtin_amdgcn_readlane(iv, 16))) + (__int_as_float(__builtin_amdgcn_readlane(iv, 32)) + __int_as_float(__builtin_amdgcn_readlane(iv, 48)));
}
__device__ __forceinline__ void wave_sum2(float& a, float& b) { a = wave_sum(a); b = wave_sum(b); }
__device__ __forceinline__ int lane_id() { int l; asm volatile("v_mbcnt_lo_u32_b32 %0, -1, 0\n\tv_mbcnt_hi_u32_b32 %0, -1, %0" : "=v"(l)); return l; }
#define LDS_WAIT() asm volatile("s_waitcnt lgkmcnt(0)" ::: "memory")
#define VM_WAIT() asm volatile("s_waitcnt vmcnt(0)" ::: "memory")

#define XB_TMO      128
#define XB_XCNT(j)  (256  + 64 * (j))
#define XB_XSUB(j)  (1280 + 64 * (j))
#define XB_XGEN(j)  (2304 + 64 * (j))
#define XB_TOP      3328
#define XB_TOPGEN   3392
#define XCD_BAR_WORDS 3456
#define XB_SPIN_CAP (1u << 18)
__device__ __forceinline__ unsigned xb_ld(unsigned* p)              { return __hip_atomic_load(p, __ATOMIC_RELAXED, __HIP_MEMORY_SCOPE_AGENT); }
__device__ __forceinline__ unsigned xb_add(unsigned* p, unsigned v) { return __hip_atomic_fetch_add(p, v, __ATOMIC_RELAXED, __HIP_MEMORY_SCOPE_AGENT); }
__device__ __forceinline__ unsigned xb_xcc_id() { return (unsigned)__builtin_amdgcn_s_getreg((3 << 11) | 20) & 0xFu; }
#define XB_SPIN(cond, bar) do { unsigned _sp = 0; while (cond) { __builtin_amdgcn_s_sleep(1); \
    if ((++_sp & 255u) == 0u) { if (xb_ld(&(bar)[XB_TMO])) break; if (_sp > XB_SPIN_CAP) { atomicAdd(&(bar)[XB_TMO], 1u); break; } } } } while (0)
struct XcdBarrier { unsigned* bar; unsigned x; volatile LAS unsigned* st; };
__device__ __forceinline__ XcdBarrier xcd_barrier_post(unsigned* bar, volatile LAS unsigned* st) {
    XcdBarrier b; b.bar = bar; b.x = xb_xcc_id(); b.st = st;
    if (threadIdx.x == 0) (void)xb_add(&bar[XB_XCNT(b.x)], 1u);
    return b;
}
__device__ __forceinline__ void xcd_barrier_complete(unsigned* bar, unsigned x, unsigned& nloc, unsigned& nx) {
    const unsigned G = gridDim.x * gridDim.y * gridDim.z;
    unsigned sum, cnt, mine, sp = 0u;
    for (;;) {
        sum = 0u; cnt = 0u; mine = 0u;
#pragma unroll
        for (unsigned j = 0; j < 16; ++j) { const unsigned c = xb_ld(&bar[XB_XCNT(j)]); sum += c; cnt += (c > 0u) ? 1u : 0u; mine = (j == x) ? c : mine; }
        if (sum == G) break;
        __builtin_amdgcn_s_sleep(1);
        if ((++sp & 255u) == 0u) { if (xb_ld(&bar[XB_TMO])) break; if (sp > XB_SPIN_CAP) { atomicAdd(&bar[XB_TMO], 1u); break; } }
    }
    nloc = mine > 0u ? mine : 1u; nx = cnt > 0u ? cnt : 1u;
}
__device__ __forceinline__ void xcd_barrier(const XcdBarrier& b, bool leader) {
    asm volatile("s_waitcnt vmcnt(0)" ::: "memory");
    __syncthreads();
    if (leader) {
        unsigned* bar = b.bar;
        __builtin_amdgcn_s_waitcnt(0);
        unsigned nloc = b.st[0], nx = b.st[1];
        if (nloc == 0u) { xcd_barrier_complete(bar, b.x, nloc, nx); b.st[0] = nloc; b.st[1] = nx; }
        const unsigned old = xb_add(&bar[XB_XSUB(b.x)], 1u);
        const unsigned gen = old / nloc;
        if (old + 1u == (gen + 1u) * nloc) {
            __builtin_amdgcn_fence(__ATOMIC_RELEASE, "agent");
            asm volatile("s_waitcnt vmcnt(0)" ::: "memory");
            const unsigned og = xb_add(&bar[XB_TOP], 1u);
            const unsigned tg = og / nx;
            if (og + 1u == (tg + 1u) * nx) xb_add(&bar[XB_TOPGEN], 1u);
            else XB_SPIN(xb_ld(&bar[XB_TOPGEN]) == tg, bar);
            __builtin_amdgcn_fence(__ATOMIC_ACQUIRE, "agent");
            xb_add(&bar[XB_XGEN(b.x)], 1u);
            asm volatile("s_waitcnt vmcnt(0)" ::: "memory");
        } else {
            XB_SPIN(xb_ld(&bar[XB_XGEN(b.x)]) == gen, bar);
            __builtin_amdgcn_fence(__ATOMIC_ACQUIRE, "agent");
            asm volatile("s_waitcnt vmcnt(0)" ::: "memory");
        }
    }
    __syncthreads();
}

namespace ge {
constexpr int BM = 256, BK = 64, HALF = 128, HTB = HALF * BK * 2, STAGE_BYTES = 8 * HTB;
__device__ __forceinline__ int lds_byte(int r, int c) { const int st = (r >> 4) * 2 + (c >> 5), rr = r & 15, cc = c & 31, ob = rr * 64 + cc * 2; return st * 1024 + (ob ^ (((ob >> 9) & 1) << 5)); }
__device__ __forceinline__ void stage_rc(int b, int& R, int& C) { const int st = b / 1024, sb = b % 1024, swz = sb ^ (((sb >> 9) & 1) << 5); R = (st >> 1) * 16 + swz / 64; C = (st & 1) * 32 + (swz % 64) / 2; }
__device__ __forceinline__ int perm32(int rho) { const int n = rho >> 4, i = rho & 15; return 8 * (i >> 2) + 4 * n + (i & 3); }

__device__ __forceinline__ void glds16(const void* sbase, unsigned voff, unsigned lds_dst) {
    unsigned keep;
    asm volatile("s_mov_b32 %0, m0\n\ts_mov_b32 m0, %3\n\ts_nop 0\n\tglobal_load_lds_dwordx4 %1, %2\n\ts_mov_b32 m0, %0" : "=&s"(keep) : "v"(voff), "s"(sbase), "s"(lds_dst) : "memory");
}
__device__ __forceinline__ const void* uniform_ptr(const void* p) { const unsigned long long v = (unsigned long long)(uintptr_t)p;
    const unsigned lo = __builtin_amdgcn_readfirstlane((unsigned)v), hi = __builtin_amdgcn_readfirstlane((unsigned)(v >> 32)); return (const void*)(uintptr_t)(((unsigned long long)hi << 32) | lo); }
__device__ __forceinline__ void glds4(const void* sbase, unsigned voff, unsigned lds_dst) {
    unsigned keep;
    asm volatile("s_mov_b32 %0, m0\n\ts_mov_b32 m0, %3\n\ts_nop 3\n\tglobal_load_lds_dword %1, %2\n\ts_mov_b32 m0, %0" : "=&s"(keep) : "v"(voff), "s"(sbase), "s"(lds_dst) : "memory");
}
constexpr int TAB_OFF = 139264 + 2048;
struct Unit {
    size_t a_off;
    const int* rows;
    int row0, nrows;
    const bf16_t* B;
    int pm, pn;
    int x0, x1;
};
__device__ __forceinline__ void static_tile(long L, int nM, int nN, int& pm, int& pn) {
    const int nwg = nM * nN; int wgid = (int)L;
    { const int q = nwg / 8, r = nwg % 8, xcd = wgid % 8, off = wgid / 8; wgid = (xcd < r ? xcd * (q + 1) : r * (q + 1) + (xcd - r) * q) + off; }
    const int nig = 8 * nN, gid = wgid / nig, fm = gid * 8, gsz = (nM - fm) < 8 ? (nM - fm) : 8;
    pm = fm + ((wgid % nig) % gsz); pn = (wgid % nig) / gsz;
}
template <int RSH> __device__ __forceinline__ unsigned arow(const Unit& u, int r) {
    return (unsigned)(u.rows[r < u.nrows ? r : 0] >> RSH);
}

template <int K, int LDA, int LDB, int RSH, int PERM, bool GATHER, bool AIL = false, bool SP2V = false, class Sched, class Epi>
__device__ __forceinline__ void gemm_phase(LAS unsigned char* lds, int tid, const bf16_t* Abase, const Sched& S, const Epi& E) {
    asm volatile("" : "+v"(tid));
    const int wid = __builtin_amdgcn_readfirstlane(tid >> 6), lane = tid & 63, wr = wid >> 2, wc = wid & 3, fr = lane & 15, fq = lane >> 4;
    constexpr int nt = K / BK;
    static_assert(K % 128 == 0, "K multiple of 128");
    int R0, C0, R1, C1; stage_rc(tid * 16, R0, C0); stage_rc(tid * 16 + 8192, R1, C1);
    const int Rb0 = PERM == 1 ? ((R0 & ~31) + perm32(R0 & 31)) : PERM == 2 ? (64 * (R0 >> 5) + 16 * ((R0 >> 2) & 3) + 4 * ((R0 >> 4) & 1) + (R0 & 3)) : PERM == 3 ? (64 * (R0 >> 5) + perm32(R0 & 31)) : PERM == 4 ? (64 * (R0 >> 5) + (R0 & 31)) : R0;
    const int Rb1 = PERM == 1 ? ((R1 & ~31) + perm32(R1 & 31)) : PERM == 2 ? (64 * (R1 >> 5) + 16 * ((R1 >> 2) & 3) + 4 * ((R1 >> 4) & 1) + (R1 & 3)) : PERM == 3 ? (64 * (R1 >> 5) + perm32(R1 & 31)) : PERM == 4 ? (64 * (R1 >> 5) + (R1 & 31)) : R1;
    const unsigned vB0 = (unsigned)(Rb0 * LDB + C0) * 2u, vB1 = (unsigned)(Rb1 * LDB + C1) * 2u;
    const unsigned cA0 = (unsigned)C0 * 2u, cA1 = (unsigned)C1 * 2u;
    constexpr size_t kstep = (size_t)BK * 2, kstepA = AIL ? (size_t)BK * 4 : (size_t)BK * 2;
    static_assert(!(AIL && GATHER), "AIL needs identity rows");
    constexpr size_t hstepB = PERM == 2 ? (size_t)8 * LDB * 2 : (PERM == 3 || PERM == 4) ? (size_t)32 * LDB * 2 : (size_t)HALF * LDB * 2;
    constexpr size_t hstepA = GATHER ? 0 : (size_t)HALF * LDA * 2;
    const unsigned vA0 = AIL ? (unsigned)((R0 >> 1) * 2 * LDA + (C0 >> 5) * 64 + (R0 & 1) * 32 + (C0 & 31)) * 2u : (unsigned)(R0 * LDA + C0) * 2u;
    const unsigned vA1 = AIL ? (unsigned)((R1 >> 1) * 2 * LDA + (C1 >> 5) * 64 + (R1 & 1) * 32 + (C1 & 31)) * 2u : (unsigned)(R1 * LDA + C1) * 2u;
    const unsigned ldsw = (unsigned)wid * 1024u;
    const unsigned ldsbase = (unsigned)(uintptr_t)lds;
    const int aoff = lds_byte(wr * 64 + fr, fq * 8), boff = lds_byte(wc * 32 + fr, fq * 8);
#define GE_SA(b, h) (((b) * 2 + (h)) * HTB)
#define GE_SB(b, h) ((4 + (b) * 2 + (h)) * HTB)
#define GE_GLDS(sbase, voff, ldsoff) ge::glds16((const void*)(sbase), (voff), ldsbase + (unsigned)(ldsoff))
#define GE_STA(bufoff, gbase, o0, o1) do { GE_GLDS(gbase, o0, (bufoff) + ldsw); GE_GLDS(gbase, o1, (bufoff) + ldsw + 8192); } while (0)
#define GE_STB(bufoff, gbase) do { GE_GLDS(gbase, vB0, (bufoff) + ldsw); GE_GLDS(gbase, vB1, (bufoff) + ldsw + 8192); } while (0)
#define GE_LDA(dst, b, h) do { _Pragma("unroll") for (int m = 0; m < 4; ++m) _Pragma("unroll") for (int k = 0; k < 2; ++k) dst[m][k] = *(const LAS bf16x8*)(lds + GE_SA(b, h) + aoff + m * 2048 + k * 1024); } while (0)
#define GE_LDB(dst, b, h) do { _Pragma("unroll") for (int n = 0; n < 2; ++n) _Pragma("unroll") for (int k = 0; k < 2; ++k) dst[n][k] = *(const LAS bf16x8*)(lds + GE_SB(b, h) + boff + n * 2048 + k * 1024); } while (0)
#define GE_MMA(ai, bj, At, Bt) do { __builtin_amdgcn_s_setprio(1); _Pragma("unroll") for (int m = 0; m < 4; ++m) _Pragma("unroll") for (int n = 0; n < 2; ++n) _Pragma("unroll") for (int k = 0; k < 2; ++k) \
        acc[ai][bj][m][n] = __builtin_amdgcn_mfma_f32_16x16x32_bf16(Bt[n][k], At[m][k], acc[ai][bj][m][n], 0, 0, 0); __builtin_amdgcn_s_setprio(0); } while (0)
#define GE_WAIT_V(n) asm volatile("s_waitcnt vmcnt(" #n ")" ::: "memory")
#define GE_WAIT_L(n) asm volatile("s_waitcnt lgkmcnt(" #n ")" ::: "memory")
#define GE_BAR __builtin_amdgcn_s_barrier()
#define GE_SCHED __builtin_amdgcn_sched_barrier(0)
    Unit cur, nxt; int ui = 0;
    if (!S.next(0, cur)) return;
    f32x4 acc[2][2][4][2];
#pragma unroll
    for (int a = 0; a < 2; ++a)
#pragma unroll
        for (int b = 0; b < 2; ++b)
#pragma unroll
            for (int m = 0; m < 4; ++m)
#pragma unroll
                for (int n = 0; n < 2; ++n) acc[a][b][m][n] = (f32x4){0.f, 0.f, 0.f, 0.f};
    bf16x8 At[4][2], B0[2][2], B1[2][2];
    unsigned oc00, oc01, oc10, oc11, on00, on01, on10, on11;
    if constexpr (GATHER) {
        oc00 = arow<RSH>(cur, R0) * (unsigned)(LDA * 2) + cA0; oc01 = arow<RSH>(cur, R1) * (unsigned)(LDA * 2) + cA1;
        oc10 = arow<RSH>(cur, HALF + R0) * (unsigned)(LDA * 2) + cA0; oc11 = arow<RSH>(cur, HALF + R1) * (unsigned)(LDA * 2) + cA1;
    } else { oc00 = vA0; oc01 = vA1; oc10 = vA0; oc11 = vA1; }
    const char* cA = (const char*)Abase + cur.a_off + (GATHER ? (size_t)0 : (size_t)cur.row0 * LDA * 2); const char* cB = (const char*)cur.B;
    const unsigned tabbase = (unsigned)(uintptr_t)lds - 0u + (unsigned)TAB_OFF;
    const int trow = wid * 64 + lane;
    if constexpr (Epi::HAS_IDX) { if (wid < 4) { const int rc = trow < cur.nrows ? trow : cur.nrows - 1; glds4(uniform_ptr(E.idx_base(cur)), (unsigned)(E.idx_off(cur) + rc) * 4u, (unsigned)__builtin_amdgcn_readfirstlane(tabbase + (unsigned)wid * 256u)); } }
    if constexpr (SP2V) {
        GE_STB(GE_SB(0, 0), cB); GE_STB(GE_SB(0, 1), cB + hstepB); GE_STA(GE_SA(0, 0), cA, oc00, oc01); GE_STA(GE_SA(0, 1), cA + hstepA, oc10, oc11);
        if (wr == 1) GE_BAR;
        GE_WAIT_V(2); GE_BAR;
    } else {
    GE_STB(GE_SB(0, 0), cB); GE_STA(GE_SA(0, 0), cA, oc00, oc01); GE_STB(GE_SB(0, 1), cB + hstepB); GE_STA(GE_SA(0, 1), cA + hstepA, oc10, oc11);
    if (wr == 1) GE_BAR;
    GE_WAIT_V(4); GE_BAR;
    }
    GE_STB(GE_SB(1, 0), cB + kstep); GE_STA(GE_SA(1, 0), cA + kstepA, oc00, oc01); GE_STB(GE_SB(1, 1), cB + hstepB + kstep);
    GE_WAIT_V(6); GE_BAR;
    for (;;) {
        const bool has_next = S.next(ui + 1, nxt);
        if (!has_next) nxt = cur;
        if constexpr (GATHER) {
            if (wid < 4) { const int rc = trow < nxt.nrows ? trow : nxt.nrows - 1; glds4(uniform_ptr(nxt.rows), (unsigned)rc * 4u, (unsigned)__builtin_amdgcn_readfirstlane(tabbase + (unsigned)(((ui + 1) & 1) * 1024 + wid * 256))); }
            on00 = oc00; on01 = oc01; on10 = oc10; on11 = oc11;
        } else { on00 = vA0; on01 = vA1; on10 = vA0; on11 = vA1; }
        const char* nA = (const char*)Abase + nxt.a_off + (GATHER ? (size_t)0 : (size_t)nxt.row0 * LDA * 2); const char* nB = (const char*)nxt.B;
#pragma unroll 1
        for (int t = 0; t < nt; t += 2) {
            const bool last = (t == nt - 2);
            const char* a1 = cA + (size_t)(t + 1) * kstepA;
            const char* a2 = last ? nA : cA + (size_t)(t + 2) * kstepA; const char* b2 = last ? nB : cB + (size_t)(t + 2) * kstep;
            const char* a3 = a2 + kstepA; const char* b3 = b2 + kstep;
            if constexpr (SP2V) {
            GE_LDB(B0, 0, 0); GE_LDB(B1, 0, 1); GE_SCHED; GE_LDA(At, 0, 0); GE_STA(GE_SA(1, 1), a1 + hstepA, oc10, oc11);
            GE_WAIT_V(8); GE_WAIT_L(0); GE_BAR; GE_MMA(0, 0, At, B0); GE_MMA(0, 1, At, B1); GE_BAR; GE_SCHED;
            if constexpr (GATHER) { if (last) {
                const LAS int* tb = (const LAS int*)(lds + TAB_OFF + ((ui + 1) & 1) * 1024);
                oc00 = (unsigned)(tb[R0] >> RSH) * (unsigned)(LDA * 2) + cA0; oc01 = (unsigned)(tb[R1] >> RSH) * (unsigned)(LDA * 2) + cA1;
                oc10 = (unsigned)(tb[HALF + R0] >> RSH) * (unsigned)(LDA * 2) + cA0; oc11 = (unsigned)(tb[HALF + R1] >> RSH) * (unsigned)(LDA * 2) + cA1; } }
            GE_LDA(At, 0, 1); GE_STB(GE_SB(0, 0), b2); GE_STB(GE_SB(0, 1), b2 + hstepB); GE_STA(GE_SA(0, 0), a2, oc00, oc01);
            GE_WAIT_V(8); GE_WAIT_L(0); GE_BAR; GE_MMA(1, 0, At, B0); GE_MMA(1, 1, At, B1); GE_BAR; GE_SCHED;
            GE_LDB(B0, 1, 0); GE_LDB(B1, 1, 1); GE_SCHED; GE_LDA(At, 1, 0); GE_STA(GE_SA(0, 1), a2 + hstepA, oc10, oc11);
            GE_WAIT_V(8); GE_WAIT_L(0); GE_BAR; GE_MMA(0, 0, At, B0); GE_MMA(0, 1, At, B1); GE_BAR; GE_SCHED;
            GE_LDA(At, 1, 1); GE_STB(GE_SB(1, 0), b3); GE_STB(GE_SB(1, 1), b3 + hstepB); GE_STA(GE_SA(1, 0), a3, oc00, oc01);
            GE_WAIT_V(8); GE_WAIT_L(0); GE_BAR; GE_MMA(1, 0, At, B0); GE_MMA(1, 1, At, B1); GE_BAR; GE_SCHED;
            } else {
            GE_LDB(B0, 0, 0); GE_SCHED; GE_LDA(At, 0, 0); GE_STA(GE_SA(1, 1), a1 + hstepA, oc10, oc11);
            GE_WAIT_L(8); GE_BAR; GE_WAIT_L(0); GE_MMA(0, 0, At, B0); GE_BAR; GE_SCHED;
            if constexpr (GATHER) { if (last) {
                const LAS int* tb = (const LAS int*)(lds + TAB_OFF + ((ui + 1) & 1) * 1024);
                oc00 = (unsigned)(tb[R0] >> RSH) * (unsigned)(LDA * 2) + cA0; oc01 = (unsigned)(tb[R1] >> RSH) * (unsigned)(LDA * 2) + cA1;
                oc10 = (unsigned)(tb[HALF + R0] >> RSH) * (unsigned)(LDA * 2) + cA0; oc11 = (unsigned)(tb[HALF + R1] >> RSH) * (unsigned)(LDA * 2) + cA1; } }
            GE_LDB(B1, 0, 1); GE_STB(GE_SB(0, 0), b2);
            GE_BAR; GE_WAIT_L(0); GE_MMA(0, 1, At, B1); GE_BAR;
            GE_LDA(At, 0, 1); GE_STA(GE_SA(0, 0), a2, oc00, oc01);
            GE_BAR; GE_WAIT_L(0); GE_MMA(1, 0, At, B0); GE_BAR; GE_SCHED;
            GE_STB(GE_SB(0, 1), b2 + hstepB);
            GE_WAIT_V(6); GE_BAR; GE_MMA(1, 1, At, B1); GE_BAR;
            GE_LDB(B0, 1, 0); GE_SCHED; GE_LDA(At, 1, 0); GE_STA(GE_SA(0, 1), a2 + hstepA, oc10, oc11);
            GE_WAIT_L(8); GE_BAR; GE_WAIT_L(0); GE_MMA(0, 0, At, B0); GE_BAR; GE_SCHED;
            GE_LDB(B1, 1, 1); GE_STB(GE_SB(1, 0), b3);
            GE_BAR; GE_WAIT_L(0); GE_MMA(0, 1, At, B1); GE_BAR;
            GE_LDA(At, 1, 1); GE_STA(GE_SA(1, 0), a3, oc00, oc01);
            GE_BAR; GE_WAIT_L(0); GE_MMA(1, 0, At, B0); GE_BAR; GE_SCHED;
            GE_STB(GE_SB(1, 1), b3 + hstepB);
            GE_WAIT_V(6); GE_BAR; GE_MMA(1, 1, At, B1); GE_BAR;
                    }
        }
        if (wr == 0) GE_BAR;
        if constexpr (Epi::HAS_IDX) E(acc, cur, wr, wc, fr, fq, (const LAS int*)(lds + TAB_OFF + (ui & 1) * 1024)); else E(acc, cur, wr, wc, fr, fq);
        if (!has_next) break;
#pragma unroll
        for (int a = 0; a < 2; ++a)
#pragma unroll
            for (int b = 0; b < 2; ++b)
#pragma unroll
                for (int m = 0; m < 4; ++m)
#pragma unroll
                    for (int n = 0; n < 2; ++n) acc[a][b][m][n] = (f32x4){0.f, 0.f, 0.f, 0.f};
        cur = nxt; cA = nA; cB = nB; ++ui;
        if (wr == 1) GE_BAR;
        if constexpr (Epi::HAS_IDX) { if (wid < 4) { const int rc = trow < cur.nrows ? trow : cur.nrows - 1; glds4(uniform_ptr(E.idx_base(cur)), (unsigned)(E.idx_off(cur) + rc) * 4u, (unsigned)__builtin_amdgcn_readfirstlane(tabbase + (unsigned)((ui & 1) * 1024 + wid * 256))); } }
    }
    GE_WAIT_V(0);
    GE_BAR;
#undef GE_SA
#undef GE_SB
#undef GE_GLDS
#undef GE_STA
#undef GE_STB
#undef GE_LDA
#undef GE_LDB
#undef GE_MMA
#undef GE_WAIT_V
#undef GE_WAIT_L
#undef GE_BAR
#undef GE_SCHED
}
}
using ge::Unit;
typedef f32x4 (&AccRef)[2][2][4][2];
typedef const f32x4 (&CAccRef)[2][2][4][2];

struct SchedStatic {
    int nM, nN, G, c; const bf16_t* B; int ldb; int acol_div; int acol_bytes;
    __device__ __forceinline__ bool next(int i, Unit& u) const {
        const long L = (long)i * G + c; if (L >= (long)nM * nN) return false;
        int pm, pn; ge::static_tile(L, nM, nN, pm, pn);
        u.a_off = acol_div ? (size_t)((pn / acol_div) * acol_bytes) : 0; u.rows = nullptr; u.row0 = pm * 256; u.nrows = 256;
        u.B = B + (size_t)pn * 256 * ldb; u.pm = pm; u.pn = pn; u.x0 = 0; u.x1 = 0; return true;
    }
};

__device__ __forceinline__ u32x4 pack8(const f32x4 v0, const f32x4 v1) {
    u32x4 w; w.x = cvt_pk_bf16(v0[0], v0[1]); w.y = cvt_pk_bf16(v0[2], v0[3]); w.z = cvt_pk_bf16(v1[0], v1[1]); w.w = cvt_pk_bf16(v1[2], v1[3]); return w;
}
__device__ __forceinline__ u32x2 pack4(const f32x4 v) { u32x2 w; w.x = cvt_pk_bf16(v[0], v[1]); w.y = cvt_pk_bf16(v[2], v[3]); return w; }
__device__ __forceinline__ u32x4 dpp_x1(u32x4 v) { u32x4 r;
    r.x = (unsigned)__builtin_amdgcn_update_dpp(0, (int)v.x, 0xB1, 0xF, 0xF, true); r.y = (unsigned)__builtin_amdgcn_update_dpp(0, (int)v.y, 0xB1, 0xF, 0xF, true);
    r.z = (unsigned)__builtin_amdgcn_update_dpp(0, (int)v.z, 0xB1, 0xF, 0xF, true); r.w = (unsigned)__builtin_amdgcn_update_dpp(0, (int)v.w, 0xB1, 0xF, 0xF, true); return r; }
__device__ __forceinline__ void st_pair(bf16_t* O, size_t ld, int row, int colb0, int fr, u32x4 w0, u32x4 w1) {
    const bool odd = (fr & 1) != 0; const u32x4 send = odd ? w0 : w1, recv = dpp_x1(send);
    bf16_t* p = O + (size_t)(row - (fr & 1)) * ld + colb0 + (odd ? 32 : 0);
    *(u32x4*)p = odd ? recv : w0; *(u32x4*)(p + ld) = odd ? w1 : recv;
}
#define LD_PAIR_ADDR(P, ld, row, colb0, fr) ((P) + (size_t)((row) - ((fr) & 1)) * (ld) + (colb0) + (((fr) & 1) ? 32 : 0))
__device__ __forceinline__ void ld_pair_fix(int fr, u32x4 l1, u32x4 l2, u32x4& w0, u32x4& w1) {
    const bool odd = (fr & 1) != 0; const u32x4 send = odd ? l1 : l2, recv = dpp_x1(send);
    w0 = odd ? recv : l1; w1 = odd ? l2 : recv;
}
__device__ __forceinline__ u32x4 join8(u32x2 p1, u32x2 p2, bool oddq) {
    const u32x2 send = oddq ? p1 : p2; u32x2 recv;
    recv.x = (unsigned)__builtin_amdgcn_ds_swizzle((int)send.x, 0x401F); recv.y = (unsigned)__builtin_amdgcn_ds_swizzle((int)send.y, 0x401F);
    return oddq ? (u32x4){recv.x, recv.y, p2.x, p2.y} : (u32x4){p1.x, p1.y, recv.x, recv.y};
}
__device__ __forceinline__ float gelu_tanh(float x) { const float z = 1.5957691216057308f * (x + 0.044715f * x * x * x); return x * __builtin_amdgcn_rcpf(1.0f + __expf(-z)); }

struct EpiWin {
    static constexpr bool HAS_IDX = false;
    bf16_t* XBR; bf16_t* Y; const float* bias;
    __device__ __forceinline__ void operator()(CAccRef acc, const Unit& u, int wr, int wc, int fr, int fq) const {
        const int row0 = u.pm * 256 + wr * 64 + fr; const bool isy = u.pn >= 4; bf16_t* dst = isy ? Y : XBR; const int cb = (u.pn & 3) * 256, bcol = u.pn * 256, cl = 64 * wc + 8 * fq;
        f32x4 bv[2][2];
#pragma unroll
        for (int bj = 0; bj < 2; ++bj) { bv[bj][0] = *(const f32x4*)(bias + bcol + cl + 32 * bj); bv[bj][1] = *(const f32x4*)(bias + bcol + cl + 32 * bj + 4); }
#pragma unroll
        for (int ai = 0; ai < 2; ++ai)
#pragma unroll
            for (int m = 0; m < 4; ++m) { u32x4 w[2];
#pragma unroll
                for (int bj = 0; bj < 2; ++bj) { f32x4 v0 = acc[ai][bj][m][0] + bv[bj][0], v1 = acc[ai][bj][m][1] + bv[bj][1];
                    if (isy) {
#pragma unroll
                        for (int e = 0; e < 4; ++e) { v0[e] = gelu_tanh(v0[e]); v1[e] = gelu_tanh(v1[e]); } }
                    w[bj] = pack8(v0, v1); }
                st_pair(dst, 1024, row0 + 128 * ai + 16 * m, cb + cl, fr, w[0], w[1]); }
    }
};
__device__ __forceinline__ float neg_expm1_small(float x) {
    float p = 1.9841270e-4f; p = p * x + 1.3888889e-3f; p = p * x + 8.3333333e-3f; p = p * x + 4.1666667e-2f; p = p * x + 1.6666667e-1f; p = p * x + 0.5f; p = p * x + 1.0f;
    return -x * p;
}
struct EpiGates {
    static constexpr bool HAS_IDX = false;
    const bf16_t* XC; unsigned char* R8; bf16_t* U; const float* ga_b; const float* gi_b; const float* sp8t;
    __device__ __forceinline__ void operator()(CAccRef acc, const Unit& u, int wr, int wc, int fr, int fq) const {
        const int row0 = u.pm * 256 + wr * 64 + fr; const int ch = (u.pn >> 1) * 256 + (u.pn & 1) * 128 + 32 * wc + 8 * fq;
        float gab[8], gib[8], sp8[8];
#pragma unroll
        for (int j = 0; j < 8; ++j) { gab[j] = ga_b[ch + j]; gib[j] = gi_b[ch + j]; sp8[j] = sp8t[ch + j] * (2.f / 255.f); }
#pragma unroll
        for (int ai = 0; ai < 2; ++ai) {
            u32x4 xws[4];
#pragma unroll
            for (int m = 0; m < 4; ++m) xws[m] = *(const u32x4*)(XC + (size_t)(row0 + 128 * ai + 16 * m) * 1024 + ch);
#pragma unroll
            for (int m = 0; m < 4; ++m) { const size_t off = (size_t)(row0 + 128 * ai + 16 * m) * 1024 + ch;
                const u32x4 xw = xws[m];
                float xc[8] = {bflo(xw.x), bfhi(xw.x), bflo(xw.y), bfhi(xw.y), bflo(xw.z), bfhi(xw.z), bflo(xw.w), bfhi(xw.w)};
                float uu[8], x2[8], pg[8], sv[8]; unsigned rq[8]; bool far_ = false;
#pragma unroll
                for (int j = 0; j < 8; ++j) { const float ga = acc[ai][0][m][j >> 2][j & 3] + gab[j], gi = acc[ai][1][m][j >> 2][j & 3] + gib[j];
                    const float r = sigmoidf_(ga); rq[j] = (unsigned)(r * 255.f + 0.5f); pg[j] = 1.0f + __expf(-gi);
                    x2[j] = (float)rq[j] * sp8[j];
                    sv[j] = neg_expm1_small(x2[j]); far_ |= x2[j] <= -0.5f; }
                if (__any(far_)) {
#pragma unroll
                    for (int j = 0; j < 8; ++j) sv[j] = x2[j] > -0.5f ? sv[j] : 1.0f - __expf(x2[j]); }
#pragma unroll
                for (int j = 0; j < 8; ++j) uu[j] = sv[j] * __builtin_amdgcn_rsqf(fmaxf(sv[j] * pg[j] * pg[j], 1e-37f)) * xc[j];
                u32x2 wr8; u32x4 wu; wr8.x = rq[0] | (rq[1] << 8) | (rq[2] << 16) | (rq[3] << 24); wr8.y = rq[4] | (rq[5] << 8) | (rq[6] << 16) | (rq[7] << 24);
                wu.x = cvt_pk_bf16(uu[0], uu[1]); wu.y = cvt_pk_bf16(uu[2], uu[3]); wu.z = cvt_pk_bf16(uu[4], uu[5]); wu.w = cvt_pk_bf16(uu[6], uu[7]);
                *(u32x2*)(R8 + off) = wr8; *(u32x4*)(U + off) = wu; }
            asm volatile("" ::: "memory"); }
    }
};
struct EpiZ {
    static constexpr bool HAS_IDX = false;
    const bf16_t* X0; bf16_t* Z;
    __device__ __forceinline__ void operator()(CAccRef acc, const Unit& u, int wr, int wc, int fr, int fq) const {
        const int row0 = u.pm * 256 + wr * 64 + fr, col0 = u.pn * 256 + wc * 64 + 8 * fq;
        u32x4 xw[2][4][2];
#pragma unroll
        for (int ai = 0; ai < 2; ++ai)
#pragma unroll
            for (int m = 0; m < 4; ++m)
#pragma unroll
                for (int bj = 0; bj < 2; ++bj) xw[ai][m][bj] = __builtin_nontemporal_load((const u32x4*)(LD_PAIR_ADDR(X0, 1024, row0 + 128 * ai + 16 * m, col0, fr) + (size_t)bj * 1024));
#pragma unroll
        for (int ai = 0; ai < 2; ++ai) {
#pragma unroll
            for (int m = 0; m < 4; ++m) { u32x4 w[2], xo[2]; ld_pair_fix(fr, xw[ai][m][0], xw[ai][m][1], xo[0], xo[1]);
#pragma unroll
                for (int bj = 0; bj < 2; ++bj) { const u32x4 x = xo[bj]; f32x4 v0, v1;
                    v0[0] = bflo(x.x); v0[1] = bfhi(x.x); v0[2] = bflo(x.y); v0[3] = bfhi(x.y); v1[0] = bflo(x.z); v1[1] = bfhi(x.z); v1[2] = bflo(x.w); v1[3] = bfhi(x.w);
                    w[bj] = pack8(v0 * DN_ALPHA + acc[ai][bj][m][0], v1 * DN_ALPHA + acc[ai][bj][m][1]); }
                st_pair(Z, 1024, row0 + 128 * ai + 16 * m, col0, fr, w[0], w[1]); }
            asm volatile("" ::: "memory"); }
    }
};
struct EpiBf16 {
    static constexpr bool HAS_IDX = false;
    bf16_t* O; int ldc;
    __device__ __forceinline__ void operator()(CAccRef acc, const Unit& u, int wr, int wc, int fr, int fq) const {
        const int row0 = u.pm * 256 + wr * 64 + fr, col0 = u.pn * 256 + wc * 64 + 8 * fq;
#pragma unroll
        for (int ai = 0; ai < 2; ++ai)
#pragma unroll
            for (int m = 0; m < 4; ++m) st_pair(O, (size_t)ldc, row0 + 128 * ai + 16 * m, col0, fr, pack8(acc[ai][0][m][0], acc[ai][0][m][1]), pack8(acc[ai][1][m][0], acc[ai][1][m][1]));
    }
};
struct EpiPle {
    static constexpr bool HAS_IDX = false;
    const bf16_t* X2; const bf16_t* PW; float* OUT; bf16_t* X3B;
    __device__ __forceinline__ void operator()(CAccRef acc, const Unit& u, int wr, int wc, int fr, int fq) const {
        const int row0 = u.pm * 256 + wr * 64 + fr, col0 = u.pn * 256 + wc * 64 + 8 * fq;
#pragma unroll
        for (int ai = 0; ai < 2; ++ai) {
            u32x4 xws[4][2], pws[4][2];
#pragma unroll
            for (int m = 0; m < 4; ++m)
#pragma unroll
                for (int bj = 0; bj < 2; ++bj) { xws[m][bj] = *(const u32x4*)(LD_PAIR_ADDR(X2, 1024, row0 + 128 * ai + 16 * m, col0, fr) + (size_t)bj * 1024);
                    pws[m][bj] = __builtin_nontemporal_load((const u32x4*)(LD_PAIR_ADDR(PW, 1024, row0 + 128 * ai + 16 * m, col0, fr) + (size_t)bj * 1024)); }
#pragma unroll
            for (int m = 0; m < 4; ++m) { u32x4 w[2], xo[2], po[2]; ld_pair_fix(fr, xws[m][0], xws[m][1], xo[0], xo[1]); ld_pair_fix(fr, pws[m][0], pws[m][1], po[0], po[1]);
#pragma unroll
                for (int bj = 0; bj < 2; ++bj) { const size_t o = (size_t)(row0 + 128 * ai + 16 * m) * 1024 + col0 + bj * 32; const u32x4 xw = xo[bj], pw = po[bj];
                    const f32x4 a0 = acc[ai][bj][m][0], a1 = acc[ai][bj][m][1]; f32x4 r0, r1;
                    r0[0] = bflo(xw.x) + bflo(pw.x) * sigmoidf_(a0[0]); r0[1] = bfhi(xw.x) + bfhi(pw.x) * sigmoidf_(a0[1]); r0[2] = bflo(xw.y) + bflo(pw.y) * sigmoidf_(a0[2]); r0[3] = bfhi(xw.y) + bfhi(pw.y) * sigmoidf_(a0[3]);
                    r1[0] = bflo(xw.z) + bflo(pw.z) * sigmoidf_(a1[0]); r1[1] = bfhi(xw.z) + bfhi(pw.z) * sigmoidf_(a1[1]); r1[2] = bflo(xw.w) + bflo(pw.w) * sigmoidf_(a1[2]); r1[3] = bfhi(xw.w) + bfhi(pw.w) * sigmoidf_(a1[3]);
                    if (OUT) { *(f32x4*)(OUT + o) = r0; *(f32x4*)(OUT + o + 4) = r1; }
                    w[bj] = pack8(r0, r1); }
                if (!OUT) st_pair(X3B, 1024, row0 + 128 * ai + 16 * m, col0, fr, w[0], w[1]); }
            asm volatile("" ::: "memory"); }
    }
};
struct EpiQ {
    static constexpr bool HAS_IDX = false;
    bf16_t* Q; const float* ROPE;
    __device__ __forceinline__ void operator()(AccRef acc, const Unit& u, int wr, int wc, int fr, int fq) const {
        const bool oddq = (fq & 1) != 0, roped = (wc & 1) == 0;
        const int row0 = u.pm * 256 + wr * 64 + fr, colb0 = u.pn * 256 + wc * 64 + (oddq ? 16 + 4 * (fq - 1) : 4 * fq); const float sc = 0.08838834764831845f;
#pragma unroll
        for (int ai = 0; ai < 2; ++ai)
#pragma unroll
            for (int m = 0; m < 4; ++m) { const int row = row0 + 128 * ai + 16 * m; const int pos = row & (SEQ - 1);
                f32x4 cs = (f32x4){1.f, 1.f, 1.f, 1.f}, sn = (f32x4){0.f, 0.f, 0.f, 0.f};
                if (roped) { cs = *(const f32x4*)(ROPE + (size_t)pos * 16 + 4 * fq); sn = *(const f32x4*)(ROPE + (size_t)SEQ * 16 + (size_t)pos * 16 + 4 * fq); }
                u32x4 w[2];
#pragma unroll
                for (int bj = 0; bj < 2; ++bj) { f32x4 x1 = acc[ai][bj][m][0], x2 = acc[ai][bj][m][1];
                    if (roped && bj == 0) { const f32x4 o1 = x1 * cs - x2 * sn, o2 = x2 * cs + x1 * sn; x1 = o1; x2 = o2; }
                    w[bj] = join8(pack4(x1 * sc), pack4(x2 * sc), oddq); }
                st_pair(Q, 1024, row, colb0, fr, w[0], w[1]); }
    }
};
struct EpiKV {
    static constexpr bool HAS_IDX = false;
    bf16_t* KB; bf16_t* VB; const float* ROPE; float* KM;
    __device__ __forceinline__ void operator()(AccRef acc, const Unit& u, int wr, int wc, int fr, int fq) const {
        const bool isv = u.pn >= 4, oddq = (fq & 1) != 0, roped = !isv && (wc & 1) == 0;
        const int row0 = u.pm * 256 + wr * 64 + fr, colb0 = (u.pn & 3) * 256 + wc * 64 + (oddq ? 16 + 4 * (fq - 1) : 4 * fq);
        bf16_t* dst = isv ? VB : KB;
        f32x4 csum[2][2];
#pragma unroll
        for (int bj = 0; bj < 2; ++bj)
#pragma unroll
            for (int n = 0; n < 2; ++n) csum[bj][n] = (f32x4){0.f, 0.f, 0.f, 0.f};
#pragma unroll
        for (int ai = 0; ai < 2; ++ai)
#pragma unroll
            for (int m = 0; m < 4; ++m) { const int row = row0 + 128 * ai + 16 * m; const int pos = row & (SEQ - 1);
                f32x4 cs = (f32x4){1.f, 1.f, 1.f, 1.f}, sn = (f32x4){0.f, 0.f, 0.f, 0.f};
                if (roped) { cs = *(const f32x4*)(ROPE + (size_t)pos * 16 + 4 * fq); sn = *(const f32x4*)(ROPE + (size_t)SEQ * 16 + (size_t)pos * 16 + 4 * fq); }
                u32x4 w[2];
#pragma unroll
                for (int bj = 0; bj < 2; ++bj) { f32x4 x1 = acc[ai][bj][m][0], x2 = acc[ai][bj][m][1];
                    if (roped && bj == 0) { const f32x4 o1 = x1 * cs - x2 * sn, o2 = x2 * cs + x1 * sn; x1 = o1; x2 = o2; }
                    csum[bj][0] += x1; csum[bj][1] += x2;
                    w[bj] = join8(pack4(x1), pack4(x2), oddq); }
                st_pair(dst, 1024, row, colb0, fr, w[0], w[1]); }
        if (!isv) {
            const int b = u.pm >> 6, blk = u.pm & 63, head = (u.pn & 3) * 2 + (wc >> 1);
#pragma unroll
            for (int bj = 0; bj < 2; ++bj)
#pragma unroll
                for (int n = 0; n < 2; ++n)
#pragma unroll
                    for (int e = 0; e < 4; ++e) { float s = row_sum16(csum[bj][n][e]);
                        if (fr == 0) { const int d = 64 * (wc & 1) + 32 * bj + 16 * n + 4 * fq + e; atomicAdd(KM + ((size_t)((b * 8 + head) * 64 + blk)) * 128 + d, s); } }
        }
    }
};

__device__ __forceinline__ void transpose_item(const float* W, int K, int N, bf16_t* WT, int k0, int n0, int drow0, LAS float* scr, int lane) {
    float wv[32];
#pragma unroll
    for (int i = 0; i < 32; ++i) wv[i] = __builtin_nontemporal_load(W + (size_t)(k0 + 2 * i + (lane >> 5)) * N + n0 + (lane & 31));
#pragma unroll
    for (int i = 0; i < 32; ++i) scr[(2 * i + (lane >> 5)) * 33 + (lane & 31)] = wv[i];
    LDS_WAIT(); asm volatile("" ::: "memory");
    const int c = lane & 7;
#pragma unroll
    for (int j = 0; j < 4; ++j) { const int n = (lane >> 3) + 8 * j; const LAS float* s = scr + (8 * c) * 33 + n;
        u32x4 o; o.x = cvt_pk_bf16(s[0 * 33], s[1 * 33]); o.y = cvt_pk_bf16(s[2 * 33], s[3 * 33]); o.z = cvt_pk_bf16(s[4 * 33], s[5 * 33]); o.w = cvt_pk_bf16(s[6 * 33], s[7 * 33]);
        *(u32x4*)(WT + (size_t)(drow0 + n) * K + k0 + 8 * c) = o; }
    LDS_WAIT(); asm volatile("" ::: "memory");
}
__device__ __forceinline__ void conv_job(const float* src, bf16_t* dst, int K, int N, int nb, size_t dstride, int mode, int& base, int gw, int NGW, LAS float* scr, int lane) {
    const int nkb = K / 64, nnb = N / 32, per = nkb * nnb, count = per * nb;
    int first = (gw - base) % NGW; if (first < 0) first += NGW;
    for (int it = first; it < count; it += NGW) {
        const int b = it / per, r = it % per, kb = r / nnb, nb_ = r % nnb, n0 = nb_ * 32;
        const int drow = mode == 0 ? n0 : ((n0 >> 7) * 256 + (mode == 2 ? 128 : 0) + (n0 & 127));
        transpose_item(src + (size_t)b * K * N, K, N, dst + (size_t)b * dstride, kb * 64, n0, drow, scr, lane);
    }
    base = (base + count) % NGW;
}
__device__ __forceinline__ void cvt_f32_bf16(const float* src, bf16_t* dst, size_t n8, size_t gtid, size_t gthreads) {
    for (size_t i = gtid; i < n8; i += gthreads) { const f32x4 a = __builtin_nontemporal_load((const f32x4*)(src + i * 8)), b = __builtin_nontemporal_load((const f32x4*)(src + i * 8 + 4)); *(u32x4*)(dst + i * 8) = pack8(a, b); }
}

__device__ __forceinline__ void ln_rows(f32x4 (&v)[4], const f32x4 (&g)[4], const f32x4 (&b)[4]) {
    float s = 0.f, s2 = 0.f;
#pragma unroll
    for (int j = 0; j < 4; ++j) { s += (v[j][0] + v[j][1]) + (v[j][2] + v[j][3]); s2 += (v[j][0] * v[j][0] + v[j][1] * v[j][1]) + (v[j][2] * v[j][2] + v[j][3] * v[j][3]); }
    wave_sum2(s, s2);
    const float mean = s * (1.f / 1024.f); const float var = fmaxf(s2 * (1.f / 1024.f) - mean * mean, 0.f);
    const float rstd = 1.0f / sqrtf(var + LN_EPS);
#pragma unroll
    for (int j = 0; j < 4; ++j) v[j] = (v[j] - mean) * rstd * g[j] + b[j];
}

__device__ __forceinline__ void phase_conv(const bf16_t* XBR, bf16_t* XC, const float* cw  , const float* cb, int gw, int NGW, int lane) {
    for (int it = gw; it < 2048; it += NGW) {
        const int chunk = it >> 1, ch = (it & 1) * 512 + lane * 8, t0 = chunk * 32;
        float w[4][8], bia[8];
#pragma unroll
        for (int k = 0; k < 4; ++k)
#pragma unroll
            for (int j = 0; j < 8; ++j) w[k][j] = cw[k * 1024 + ch + j];
#pragma unroll
        for (int j = 0; j < 8; ++j) bia[j] = cb[ch + j];
        float x0[8], x1[8], x2[8];
        const bool has_prev = (t0 & (SEQ - 1)) != 0;
        u32x4 p0 = (u32x4){0u, 0u, 0u, 0u}, p1 = p0, p2 = p0;
        if (has_prev) { p0 = *(const u32x4*)(XBR + (size_t)(t0 - 3) * 1024 + ch); p1 = *(const u32x4*)(XBR + (size_t)(t0 - 2) * 1024 + ch); p2 = *(const u32x4*)(XBR + (size_t)(t0 - 1) * 1024 + ch); }
#define UNPK(dst, w4) do { dst[0] = bflo(w4.x); dst[1] = bfhi(w4.x); dst[2] = bflo(w4.y); dst[3] = bfhi(w4.y); dst[4] = bflo(w4.z); dst[5] = bfhi(w4.z); dst[6] = bflo(w4.w); dst[7] = bfhi(w4.w); } while (0)
        UNPK(x0, p0); UNPK(x1, p1); UNPK(x2, p2);
#pragma unroll 1
        for (int rb = 0; rb < 32; rb += 8) {
            u32x4 in8[8];
#pragma unroll
            for (int r = 0; r < 8; ++r) in8[r] = __builtin_nontemporal_load((const u32x4*)(XBR + (size_t)(t0 + rb + r) * 1024 + ch));
#pragma unroll
            for (int r = 0; r < 8; ++r) { float x3[8]; UNPK(x3, in8[r]); float o[8];
#pragma unroll
                for (int j = 0; j < 8; ++j) { o[j] = bia[j] + x0[j] * w[0][j] + x1[j] * w[1][j] + x2[j] * w[2][j] + x3[j] * w[3][j]; x0[j] = x1[j]; x1[j] = x2[j]; x2[j] = x3[j]; }
                u32x4 ow; ow.x = cvt_pk_bf16(o[0], o[1]); ow.y = cvt_pk_bf16(o[2], o[3]); ow.z = cvt_pk_bf16(o[4], o[5]); ow.w = cvt_pk_bf16(o[6], o[7]);
                *(u32x4*)(XC + (size_t)(t0 + rb + r) * 1024 + ch) = ow; }
        }
    }
}
#define SC_LA4(l, w, s4) const float l##0 = (float)((w) & 0xffu) * s4[0], l##1 = (float)(((w) >> 8) & 0xffu) * s4[1], l##2 = (float)(((w) >> 16) & 0xffu) * s4[2], l##3 = (float)((w) >> 24) * s4[3]
__device__ __forceinline__ void phase_scan1(const unsigned char* R8, const bf16_t* U, const float* sp8t, float* CH, float* CL, int gw, int NGW, int lane) {
    for (int it = gw; it < 2048; it += NGW) {
        const int chunk = it >> 2, ch = (it & 3) * 256 + lane * 4, t0 = chunk * 64;
        const f32x4 s4 = *(const f32x4*)(sp8t + ch) * (1.f / 255.f);
        float h[4] = {0.f, 0.f, 0.f, 0.f}, ls[4] = {0.f, 0.f, 0.f, 0.f};
#pragma unroll 1
        for (int rb = 0; rb < 64; rb += 16) {
            unsigned lw[16]; u32x2 uw[16];
#pragma unroll
            for (int r = 0; r < 16; ++r) { lw[r] = *(const unsigned*)(R8 + (size_t)(t0 + rb + r) * 1024 + ch); uw[r] = *(const u32x2*)(U + (size_t)(t0 + rb + r) * 1024 + ch); }
#pragma unroll
            for (int r = 0; r < 16; ++r) { SC_LA4(l, lw[r], s4);
                h[0] = __expf(l0) * h[0] + bflo(uw[r].x); h[1] = __expf(l1) * h[1] + bfhi(uw[r].x); h[2] = __expf(l2) * h[2] + bflo(uw[r].y); h[3] = __expf(l3) * h[3] + bfhi(uw[r].y);
                ls[0] += l0; ls[1] += l1; ls[2] += l2; ls[3] += l3; }
        }
        *(f32x4*)(CH + (size_t)chunk * 1024 + ch) = (f32x4){h[0], h[1], h[2], h[3]}; *(f32x4*)(CL + (size_t)chunk * 1024 + ch) = (f32x4){ls[0], ls[1], ls[2], ls[3]};
    }
}
__device__ __forceinline__ void phase_scan_carry(const float* CH, const float* CL, float* CIN, int tid, LAS unsigned char* lds, int G) {
    asm volatile("" : "+v"(tid)); const int wave = __builtin_amdgcn_readfirstlane(tid >> 6), lane = tid & 63;
    LAS float* agg = (LAS float*)lds;
    for (int g = blockIdx.x; g < 32; g += G) {
        const int b = g >> 4, ch = (g & 15) * 64 + lane;
        const size_t o0 = (size_t)(b * 256 + wave * 32) * 1024 + ch;
        float av[32], hv[32];
#pragma unroll
        for (int c = 0; c < 32; ++c) { av[c] = CL[o0 + (size_t)c * 1024]; hv[c] = CH[o0 + (size_t)c * 1024]; }
        float A = 1.f, H = 0.f;
#pragma unroll
        for (int c = 0; c < 32; ++c) { av[c] = __expf(av[c]); H = av[c] * H + hv[c]; A *= av[c]; }
        agg[(wave * 2) * 64 + lane] = A; agg[(wave * 2 + 1) * 64 + lane] = H;
        __syncthreads();
        float h = 0.f;
        for (int w = 0; w < wave; ++w) h = agg[(w * 2) * 64 + lane] * h + agg[(w * 2 + 1) * 64 + lane];
#pragma unroll
        for (int c = 0; c < 32; ++c) { CIN[o0 + (size_t)c * 1024] = h; h = av[c] * h + hv[c]; }
        __syncthreads();
    }
}
__device__ __forceinline__ void phase_scan2(const unsigned char* R8, const bf16_t* U, const bf16_t* Y, const float* sp8t, const float* CIN, bf16_t* HY, int gw, int NGW, int lane) {
    for (int it = gw; it < 2048; it += NGW) {
        const int chunk = it >> 2, ch = (it & 3) * 256 + lane * 4, t0 = chunk * 64;
        const f32x4 s4 = *(const f32x4*)(sp8t + ch) * (1.f / 255.f);
        const f32x4 hin = *(const f32x4*)(CIN + (size_t)chunk * 1024 + ch); float h[4] = {hin[0], hin[1], hin[2], hin[3]};
#pragma unroll 1
        for (int rb = 0; rb < 64; rb += 16) {
            unsigned lw[16]; u32x2 uw[16], yw[16];
#pragma unroll
            for (int r = 0; r < 16; ++r) { const size_t o = (size_t)(t0 + rb + r) * 1024 + ch; lw[r] = __builtin_nontemporal_load((const unsigned*)(R8 + o)); uw[r] = __builtin_nontemporal_load((const u32x2*)(U + o)); yw[r] = __builtin_nontemporal_load((const u32x2*)(Y + o)); }
#pragma unroll
            for (int r = 0; r < 16; ++r) { const size_t o = (size_t)(t0 + rb + r) * 1024 + ch; SC_LA4(l, lw[r], s4);
                h[0] = __expf(l0) * h[0] + bflo(uw[r].x); h[1] = __expf(l1) * h[1] + bfhi(uw[r].x); h[2] = __expf(l2) * h[2] + bflo(uw[r].y); h[3] = __expf(l3) * h[3] + bfhi(uw[r].y);
                u32x2 ow; ow.x = cvt_pk_bf16(h[0] * bflo(yw[r].x), h[1] * bfhi(yw[r].x)); ow.y = cvt_pk_bf16(h[2] * bflo(yw[r].y), h[3] * bfhi(yw[r].y)); *(u32x2*)(HY + o) = ow; }
        }
    }
}
#undef SC_LA4

constexpr int R1_ROWB = 1040, R1_WAVEB = 16 * R1_ROWB;
__device__ __forceinline__ void phase_r1(int tid, const float* lng, const float* lnb, bf16_t* X1B, const bf16_t* Wr, const float* rbias,
                                         unsigned* ecnt, int* elist, float* wpair, int* ppos, LAS unsigned char* lds, int G) {
    asm volatile("" : "+v"(tid)); const int wave = __builtin_amdgcn_readfirstlane(tid >> 6), lane = tid & 63;
    LAS unsigned* hist = (LAS unsigned*)(lds + MISC_OFF + MS_TAB); LAS unsigned* basev = hist + 64;
    LAS unsigned char* xw = lds + wave * R1_WAVEB;
    f32x4 g[4], bb[4];
#pragma unroll
    for (int j = 0; j < 4; ++j) { const int c = 8 * lane + 512 * (j >> 1) + 4 * (j & 1); g[j] = *(const f32x4*)(lng + c); bb[j] = *(const f32x4*)(lnb + c); }
    for (int rb = blockIdx.x; rb < NTOK / 128; rb += G) {
        if (tid < 64) hist[tid] = 0u;
        __syncthreads();
        const size_t row0 = (size_t)rb * 128 + wave * 16;
        u32x4 hi2[16];
        {   u32x4 zin[16][2];
#pragma unroll
            for (int r = 0; r < 16; ++r)
#pragma unroll
                for (int jj = 0; jj < 2; ++jj) zin[r][jj] = *(const u32x4*)(X1B + (row0 + r) * 1024 + 8 * lane + 512 * jj);
#pragma unroll
            for (int r = 0; r < 16; ++r) { f32x4 v[4];
#pragma unroll
                for (int jj = 0; jj < 2; ++jj) { const u32x4 zw = zin[r][jj]; v[2 * jj] = (f32x4){bflo(zw.x), bfhi(zw.x), bflo(zw.y), bfhi(zw.y)}; v[2 * jj + 1] = (f32x4){bflo(zw.z), bfhi(zw.z), bflo(zw.w), bfhi(zw.w)}; }
                ln_rows(v, g, bb);
#pragma unroll
                for (int jj = 0; jj < 2; ++jj) { const u32x4 w = pack8(v[2 * jj], v[2 * jj + 1]); *(u32x4*)(X1B + (row0 + r) * 1024 + 8 * lane + 512 * jj) = w;
                    if (jj == 0) *(LAS u32x4*)(xw + r * R1_ROWB + (8 * lane) * 2) = w; else hi2[r] = w; }
            }
        }
        LDS_WAIT(); asm volatile("" ::: "memory");
        f32x4 acc[4];
#pragma unroll
        for (int q = 0; q < 4; ++q) acc[q] = (f32x4){0.f, 0.f, 0.f, 0.f};
#pragma unroll
        for (int kh = 0; kh < 2; ++kh) {
            if (kh == 1) {
                asm volatile("" ::: "memory");
#pragma unroll
                for (int r = 0; r < 16; ++r) *(LAS u32x4*)(xw + r * R1_ROWB + (8 * lane) * 2) = hi2[r];
                LDS_WAIT(); asm volatile("" ::: "memory");
            }
#pragma unroll 4
            for (int ks = 0; ks < 16; ++ks) {
                const bf16x8 a = *(const LAS bf16x8*)(xw + (lane & 15) * R1_ROWB + (ks * 32 + 8 * (lane >> 4)) * 2);
#pragma unroll
                for (int q = 0; q < 4; ++q) { const bf16x8 b = *(const bf16x8*)(Wr + (size_t)(16 * q + (lane & 15)) * 1024 + kh * 512 + ks * 32 + 8 * (lane >> 4));
                    acc[q] = __builtin_amdgcn_mfma_f32_16x16x32_bf16(a, b, acc[q], 0, 0, 0); }
            }
            LDS_WAIT();
        }
        asm volatile("" ::: "memory");
        LAS float* ss = (LAS float*)xw; LAS float* sc = ss + 1024;
#pragma unroll
        for (int q = 0; q < 4; ++q) { const int e = 16 * q + (lane & 15); const float rbv = rbias[e];
#pragma unroll
            for (int r = 0; r < 4; ++r) { const int trow = 4 * (lane >> 4) + r; const float s = sigmoidf_(acc[q][r]); ss[trow * 64 + e] = s; sc[trow * 64 + e] = s + rbv; } }
        LDS_WAIT(); asm volatile("" ::: "memory");
        const int trow = lane >> 2, part = lane & 3;
        int e_m0 = 0, e_m1 = 0; float w_m0 = 0.f, w_m1 = 0.f;
        {
            const LAS float* cp = sc + trow * 64 + 16 * part; const LAS float* s0 = ss + trow * 64;
            const float NEG = -__builtin_inff();
            float c[16];
#pragma unroll
            for (int q = 0; q < 4; ++q) { const f32x4 t4 = *(const LAS f32x4*)(cp + 4 * q); c[4 * q] = t4[0]; c[4 * q + 1] = t4[1]; c[4 * q + 2] = t4[2]; c[4 * q + 3] = t4[3]; }
            float gsv[2];
#pragma unroll
            for (int gi = 0; gi < 2; ++gi) { float m1 = NEG, m2 = NEG;
#pragma unroll
                for (int j = 0; j < 8; ++j) { const float x = c[gi * 8 + j]; const float nm1 = fmaxf(m1, x); m2 = fmaxf(m2, fminf(m1, x)); m1 = nm1; }
                gsv[gi] = m1 + m2; }
            float gs[8];
#define QB(v, P) __int_as_float(__builtin_amdgcn_update_dpp(0, __float_as_int(v), (P) * 0x55, 0xF, 0xF, true))
            gs[0] = QB(gsv[0], 0); gs[1] = QB(gsv[1], 0); gs[2] = QB(gsv[0], 1); gs[3] = QB(gsv[1], 1); gs[4] = QB(gsv[0], 2); gs[5] = QB(gsv[1], 2); gs[6] = QB(gsv[0], 3); gs[7] = QB(gsv[1], 3);
#undef QB
            unsigned gmask = 0u;
#pragma unroll
            for (int it = 0; it < 4; ++it) { float best = NEG; int bi = 0;
#pragma unroll
                for (int gi = 0; gi < 8; ++gi) { const bool free_ = ((gmask >> gi) & 1u) == 0u; if (free_ && gs[gi] > best) { best = gs[gi]; bi = gi; } }
                gmask |= 1u << bi; }
            unsigned taken = (((gmask >> (2 * part)) & 1u) ? 0u : 0xffu) | (((gmask >> (2 * part + 1)) & 1u) ? 0u : 0xff00u);
            int e_all[8];
#pragma unroll
            for (int k = 0; k < 8; ++k) { float best = NEG; int bi = 0;
#pragma unroll
                for (int e2 = 0; e2 < 16; ++e2) { const bool free_ = ((taken >> e2) & 1u) == 0u; if (free_ && c[e2] > best) { best = c[e2]; bi = e2; } }
                int ge = 16 * part + bi;
                {   const float ov = __int_as_float(__builtin_amdgcn_update_dpp(0, __float_as_int(best), 0xB1, 0xF, 0xF, true)); const int oi = __builtin_amdgcn_update_dpp(0, ge, 0xB1, 0xF, 0xF, true);
                    const bool take = ov > best || (ov == best && oi < ge); best = take ? ov : best; ge = take ? oi : ge; }
                {   const float ov = __int_as_float(__builtin_amdgcn_update_dpp(0, __float_as_int(best), 0x4E, 0xF, 0xF, true)); const int oi = __builtin_amdgcn_update_dpp(0, ge, 0x4E, 0xF, 0xF, true);
                    const bool take = ov > best || (ov == best && oi < ge); best = take ? ov : best; ge = take ? oi : ge; }
                taken |= ((ge >> 4) == part) ? (1u << (ge & 15)) : 0u;
                e_all[k] = ge; }
            float w_all[8]; float wsum = 0.f;
#pragma unroll
            for (int k = 0; k < 8; ++k) w_all[k] = s0[e_all[k]];
#pragma unroll
            for (int k = 0; k < 8; ++k) wsum += w_all[k];
            const float inv = 2.5f / wsum;
#pragma unroll
            for (int k = 0; k < 8; ++k) { const bool mine = part == (k >> 1);
                if (k & 1) { e_m1 = mine ? e_all[k] : e_m1; w_m1 = mine ? w_all[k] * inv : w_m1; } else { e_m0 = mine ? e_all[k] : e_m0; w_m0 = mine ? w_all[k] * inv : w_m0; } }
        }
        LDS_WAIT(); asm volatile("" ::: "memory");
        const int slot0 = (int)__hip_atomic_fetch_add((LAS unsigned*)&hist[e_m0], 1u, __ATOMIC_RELAXED, __HIP_MEMORY_SCOPE_WORKGROUP);
        const int slot1 = (int)__hip_atomic_fetch_add((LAS unsigned*)&hist[e_m1], 1u, __ATOMIC_RELAXED, __HIP_MEMORY_SCOPE_WORKGROUP);
        __syncthreads();
        if (tid < 64) basev[tid] = __hip_atomic_fetch_add(ecnt + tid, hist[tid], __ATOMIC_RELAXED, __HIP_MEMORY_SCOPE_AGENT);
        __syncthreads();
        {   const int token = rb * 128 + wave * 16 + trow, pair = token * 8 + 2 * part;
            const int pos0 = (int)basev[e_m0] + slot0, pos1 = (int)basev[e_m1] + slot1;
            elist[(size_t)e_m0 * 32768 + pos0] = pair; elist[(size_t)e_m1 * 32768 + pos1] = pair + 1;
            *(f32x2*)(wpair + pair) = (f32x2){w_m0, w_m1}; *(u32x2*)(ppos + pair) = (u32x2){(unsigned)((e_m0 << 20) | pos0), (unsigned)((e_m1 << 20) | pos1)}; }
        __syncthreads();
    }
}

struct MoeTab { LAS int* tstart; LAS int* sbase; LAS int* scnt; LAS unsigned char* tseg; };
template <bool TSEG> __device__ __forceinline__ MoeTab moe_tables(int tid, unsigned* ecnt, LAS unsigned char* lds) {
    MoeTab T; T.tstart = (LAS int*)(lds + MISC_OFF + MS_TAB); T.sbase = T.tstart + 132; T.scnt = T.sbase + 132; T.tseg = lds + MISC_OFF + 4096;

    __syncthreads();
    if (tid < 64) T.scnt[tid] = (int)__hip_atomic_load(ecnt + tid, __ATOMIC_RELAXED, __HIP_MEMORY_SCOPE_AGENT);
    __syncthreads();
    if (tid < 64) {
        int t = 0, s = 0;
#pragma unroll
        for (int q = 0; q < 16; ++q) { const i32x4 c4 = *(const LAS i32x4*)(T.scnt + 4 * q);
#pragma unroll
            for (int e = 0; e < 4; ++e) { const bool below = (4 * q + e) < tid; const int tl = (c4[e] + 255) >> 8; t += below ? tl : 0; s += below ? (tl << 8) : 0; } }
        T.tstart[tid] = t; T.sbase[tid] = s;
        if (tid == 63) { const int c = T.scnt[63]; T.tstart[64] = t + ((c + 255) >> 8); T.sbase[64] = s + (((c + 255) >> 8) << 8); } }
    __syncthreads();
    if constexpr (TSEG) {
        const int TR = T.tstart[64];
        for (int tile = tid; tile < TR; tile += NTHR) { int lo = 0, hi = 64;
#pragma unroll
            for (int it = 0; it < 6; ++it) { const int mid = (lo + hi) >> 1; const bool ge = T.tstart[mid] <= tile; lo = ge ? mid : lo; hi = ge ? hi : mid; }
            T.tseg[tile] = (unsigned char)lo; }
        __syncthreads();
    }
    return T;
}
__device__ __forceinline__ MoeTab moe_tables_view(LAS unsigned char* lds) {
    MoeTab T; T.tstart = (LAS int*)(lds + MISC_OFF + MS_TAB); T.sbase = T.tstart + 132; T.scnt = T.sbase + 132; T.tseg = lds + MISC_OFF + 4096; return T;
}
__device__ __forceinline__ int moe_find_seg(const MoeTab& T, int tile) { return (int)T.tseg[tile]; }
struct SchedMoe1 {
    MoeTab T; int G, c; const int* elist; const bf16_t* egu; const bf16_t* shgu; const int* idl;
    __device__ __forceinline__ bool next(int i, Unit& u) const {
        const int TR = T.tstart[64]; const long L = (long)i * G + c; if (L >= (long)(TR + 128) * 2) return false;
        const int tile = (int)(L >> 1), jn = (int)(L & 1); u.a_off = 0; u.pn = jn; u.x1 = 0;
        if (tile < TR) { const int seg = moe_find_seg(T, tile), mt = tile - T.tstart[seg], cnt = T.scnt[seg];
            u.rows = elist + (size_t)seg * 32768 + mt * 256; u.row0 = 0; u.nrows = (cnt - mt * 256) < 256 ? (cnt - mt * 256) : 256;
            u.B = egu + ((size_t)seg * 512 + jn * 256) * 1024; u.pm = T.sbase[seg] + mt * 256; u.x0 = 0;
        } else { const int mt = tile - TR; u.rows = idl + mt * 256; u.row0 = mt * 256; u.nrows = 256; u.B = shgu + (size_t)jn * 256 * 1024; u.pm = mt * 256; u.x0 = 1; }
        return true;
    }
};
struct EpiMoe1 {
    static constexpr bool HAS_IDX = false;
    bf16_t* HDN; bf16_t* HSH;
    __device__ __forceinline__ void operator()(CAccRef acc, const Unit& u, int wr, int wc, int fr, int fq) const {
        bf16_t* out = u.x0 ? HSH : HDN; const int cl = u.pn * 128 + 32 * wc + 8 * fq;
#pragma unroll
        for (int ai = 0; ai < 2; ++ai)
#pragma unroll
            for (int m = 0; m < 4; ++m) { const int r = 128 * ai + 64 * wr + 16 * m + fr;
                if (r < u.nrows) { f32x4 h0, h1;
#pragma unroll
                    for (int e = 0; e < 4; ++e) { const float g0 = acc[ai][0][m][0][e], g1 = acc[ai][0][m][1][e];
                        h0[e] = g0 * sigmoidf_(g0) * acc[ai][1][m][0][e]; h1[e] = g1 * sigmoidf_(g1) * acc[ai][1][m][1][e]; }
                    const int rg = u.pm + r;
                    *(u32x4*)(out + (size_t)(rg >> 1) * 512 + (u.pn * 4 + wc) * 64 + (rg & 1) * 32 + 8 * fq) = pack8(h0, h1); } asm volatile("" ::: "memory"); }
    }
};
struct SchedMoe2 {
    MoeTab T; int G, c; const int* elist; const bf16_t* ed; const bf16_t* shd;
    __device__ __forceinline__ bool next(int i, Unit& u) const {
        const int T0 = 0, TH = T.tstart[64], TS = 128;
        const long L = (long)i * G + c; if (L >= (long)(TH + TS) * 4) return false;
        const int tile = (int)(L >> 2), pn = (int)(L & 3); u.pn = pn; u.rows = nullptr; u.pm = 0;
        if (tile < TH) { const int seg = moe_find_seg(T, T0 + tile), mt = T0 + tile - T.tstart[seg], cnt = T.scnt[seg];
            u.a_off = 0; u.row0 = T.sbase[seg] + mt * 256; u.nrows = (cnt - mt * 256) < 256 ? (cnt - mt * 256) : 256;
            u.B = ed + ((size_t)seg * 1024 + pn * 256) * 256; u.x0 = 0; u.x1 = seg * 32768 + mt * 256;
        } else { const int mt = tile - TH; u.a_off = WS_HSH - WS_HDN; u.row0 = mt * 256; u.nrows = 256; u.B = shd + (size_t)pn * 256 * 256; u.x0 = 1; u.x1 = mt * 256; }
        return true;
    }
};
__device__ __forceinline__ unsigned pk4_fp8(float a, float b, float c, float d) { int w = __builtin_amdgcn_cvt_pk_fp8_f32(a, b, 0, false); w = __builtin_amdgcn_cvt_pk_fp8_f32(c, d, w, true); return (unsigned)w; }
struct EpiMoe2 {
    static constexpr bool HAS_IDX = false;
    unsigned char* YP; unsigned char* YSH;
    __device__ __forceinline__ void operator()(CAccRef acc, const Unit& u, int wr, int wc, int fr, int fq) const {
        const int cl = u.pn * 256 + 64 * wc + 16 * fq;
        unsigned char* base = (unsigned char*)((uintptr_t)YP + (uintptr_t)(unsigned)u.x0 * ((uintptr_t)YSH - (uintptr_t)YP)) + (size_t)u.row0 * 1024;
#pragma unroll
        for (int ai = 0; ai < 2; ++ai)
#pragma unroll
            for (int m = 0; m < 4; ++m) { const int r = 128 * ai + 64 * wr + 16 * m + fr;
                const f32x4 a0 = acc[ai][0][m][0] * 16.f, a1 = acc[ai][0][m][1] * 16.f, b0 = acc[ai][1][m][0] * 16.f, b1 = acc[ai][1][m][1] * 16.f;
                u32x4 w; w.x = pk4_fp8(a0[0], a0[1], a0[2], a0[3]); w.y = pk4_fp8(a1[0], a1[1], a1[2], a1[3]); w.z = pk4_fp8(b0[0], b0[1], b0[2], b0[3]); w.w = pk4_fp8(b1[0], b1[1], b1[2], b1[3]);
                if (r < u.nrows) *(u32x4*)(base + (size_t)r * 1024 + cl) = w; }
    }
};
struct GB16 { float g[16], b[16]; };
__device__ __forceinline__ GB16 load_gb16(const float* lng, const float* lnb, int lane) { GB16 r;
#pragma unroll
    for (int q = 0; q < 4; ++q) { const f32x4 g = *(const f32x4*)(lng + 16 * lane + 4 * q), b = *(const f32x4*)(lnb + 16 * lane + 4 * q);
#pragma unroll
        for (int e = 0; e < 4; ++e) { r.g[4 * q + e] = g[e]; r.b[4 * q + e] = b[e]; } }
    return r; }
__device__ __forceinline__ void ln16(float (&v)[16], const GB16& gb) {
    float s = 0.f, s2 = 0.f;
#pragma unroll
    for (int j = 0; j < 16; ++j) { s += v[j]; s2 += v[j] * v[j]; }
    wave_sum2(s, s2);
    const float mean = s * (1.f / 1024.f); const float var = fmaxf(s2 * (1.f / 1024.f) - mean * mean, 0.f);
    const float rstd = 1.0f / sqrtf(var + LN_EPS);
#pragma unroll
    for (int j = 0; j < 16; ++j) v[j] = (v[j] - mean) * rstd * gb.g[j] + gb.b[j];
}
__device__ __forceinline__ void ld16_bf16(float (&v)[16], const bf16_t* p) { const u32x4 a = *(const u32x4*)p, b = *(const u32x4*)(p + 8);
    v[0] = bflo(a.x); v[1] = bfhi(a.x); v[2] = bflo(a.y); v[3] = bfhi(a.y); v[4] = bflo(a.z); v[5] = bfhi(a.z); v[6] = bflo(a.w); v[7] = bfhi(a.w);
    v[8] = bflo(b.x); v[9] = bfhi(b.x); v[10] = bflo(b.y); v[11] = bfhi(b.y); v[12] = bflo(b.z); v[13] = bfhi(b.z); v[14] = bflo(b.w); v[15] = bfhi(b.w); }
__device__ __forceinline__ void st16_bf16(bf16_t* p, const float (&v)[16]) { u32x4 a, b;
    a.x = cvt_pk_bf16(v[0], v[1]); a.y = cvt_pk_bf16(v[2], v[3]); a.z = cvt_pk_bf16(v[4], v[5]); a.w = cvt_pk_bf16(v[6], v[7]);
    b.x = cvt_pk_bf16(v[8], v[9]); b.y = cvt_pk_bf16(v[10], v[11]); b.z = cvt_pk_bf16(v[12], v[13]); b.w = cvt_pk_bf16(v[14], v[15]); *(u32x4*)p = a; *(u32x4*)(p + 8) = b; }
__device__ __forceinline__ void fma16_fp8(float (&v)[16], const u32x4 w, float s) {
    const unsigned ww[4] = {w.x, w.y, w.z, w.w};
#pragma unroll
    for (int q = 0; q < 4; ++q) { const f32x2 lo = __builtin_amdgcn_cvt_pk_f32_fp8((int)ww[q], false), hi = __builtin_amdgcn_cvt_pk_f32_fp8((int)ww[q], true);
        v[4 * q] += s * lo[0]; v[4 * q + 1] += s * lo[1]; v[4 * q + 2] += s * hi[0]; v[4 * q + 3] += s * hi[1]; }
}
__device__ __forceinline__ void phase_m4(const float* lng, const float* lnb, bf16_t* X, const unsigned char* YP, const unsigned char* YSH, const float* wpair, const int* ppos, const LAS int* sbase, int gw, int NGW, int lane) {
    const GB16 gb = load_gb16(lng, lnb, lane);
    for (int tl0 = 2 * gw; tl0 < NTOK; tl0 += 2 * NGW) {
        u32x4 xa[2], xb[2], ys[2], yw[2][8]; f32x4 w03[2], w47[2]; int pp[2][8];
#pragma unroll
        for (int q = 0; q < 2; ++q) { const size_t row = (size_t)tl0 + q;
            const u32x4 p0 = __builtin_nontemporal_load((const u32x4*)(ppos + row * 8)), p1 = __builtin_nontemporal_load((const u32x4*)(ppos + row * 8 + 4));
            pp[q][0] = (int)p0.x; pp[q][1] = (int)p0.y; pp[q][2] = (int)p0.z; pp[q][3] = (int)p0.w; pp[q][4] = (int)p1.x; pp[q][5] = (int)p1.y; pp[q][6] = (int)p1.z; pp[q][7] = (int)p1.w;
            xa[q] = *(const u32x4*)(X + row * 1024 + 16 * lane); xb[q] = *(const u32x4*)(X + row * 1024 + 16 * lane + 8); ys[q] = __builtin_nontemporal_load((const u32x4*)(YSH + row * 1024 + 16 * lane));
            w03[q] = __builtin_nontemporal_load((const f32x4*)(wpair + row * 8)); w47[q] = __builtin_nontemporal_load((const f32x4*)(wpair + row * 8 + 4)); }
#pragma unroll
        for (int q = 0; q < 2; ++q)
#pragma unroll
            for (int k = 0; k < 8; ++k) { const int yrow = sbase[pp[q][k] >> 20] + (pp[q][k] & 0xfffff); yw[q][k] = __builtin_nontemporal_load((const u32x4*)(YP + (size_t)yrow * 1024 + 16 * lane)); }
#pragma unroll
        for (int q = 0; q < 2; ++q) { const size_t row = (size_t)tl0 + q; float v[16];
            v[0] = bflo(xa[q].x); v[1] = bfhi(xa[q].x); v[2] = bflo(xa[q].y); v[3] = bfhi(xa[q].y); v[4] = bflo(xa[q].z); v[5] = bfhi(xa[q].z); v[6] = bflo(xa[q].w); v[7] = bfhi(xa[q].w);
            v[8] = bflo(xb[q].x); v[9] = bfhi(xb[q].x); v[10] = bflo(xb[q].y); v[11] = bfhi(xb[q].y); v[12] = bflo(xb[q].z); v[13] = bfhi(xb[q].z); v[14] = bflo(xb[q].w); v[15] = bfhi(xb[q].w);
#pragma unroll
            for (int j = 0; j < 16; ++j) v[j] *= DN_ALPHA;
            fma16_fp8(v, ys[q], 1.f / 16.f);
#pragma unroll
            for (int k = 0; k < 8; ++k) { const float wk = (k < 4 ? w03[q][k & 3] : w47[q][k & 3]) * (1.f / 16.f); fma16_fp8(v, yw[q][k], wk); }
            ln16(v, gb);
            st16_bf16(X + row * 1024 + 16 * lane, v); }
    }
}
__device__ __forceinline__ void phase_ln_rows(const bf16_t* src, const float* lng, const float* lnb, bf16_t* dstb, int gw, int NGW, int lane) {
    const GB16 gb = load_gb16(lng, lnb, lane);
    for (int t0 = 4 * gw; t0 < NTOK; t0 += 4 * NGW) { u32x4 a[4], b[4];
#pragma unroll
        for (int q = 0; q < 4; ++q) { a[q] = *(const u32x4*)(src + (size_t)(t0 + q) * 1024 + 16 * lane); b[q] = *(const u32x4*)(src + (size_t)(t0 + q) * 1024 + 16 * lane + 8); }
#pragma unroll
        for (int q = 0; q < 4; ++q) { float v[16];
            v[0] = bflo(a[q].x); v[1] = bfhi(a[q].x); v[2] = bflo(a[q].y); v[3] = bfhi(a[q].y); v[4] = bflo(a[q].z); v[5] = bfhi(a[q].z); v[6] = bflo(a[q].w); v[7] = bfhi(a[q].w);
            v[8] = bflo(b[q].x); v[9] = bfhi(b[q].x); v[10] = bflo(b[q].y); v[11] = bfhi(b[q].y); v[12] = bflo(b[q].z); v[13] = bfhi(b[q].z); v[14] = bflo(b[q].w); v[15] = bfhi(b[q].w);
            ln16(v, gb); st16_bf16(dstb + (size_t)(t0 + q) * 1024 + 16 * lane, v); } }
}

__device__ __forceinline__ void phase_gate(int tid, const bf16_t* Q, const float* KM, unsigned* acnt, int* alist, LAS unsigned char* lds, int G) {
    asm volatile("" : "+v"(tid)); const int  wave = __builtin_amdgcn_readfirstlane(tid >> 6), lane = tid & 63;
    LAS float* gl = (LAS float*)lds;
    LAS unsigned* hist = (LAS unsigned*)(lds + MISC_OFF + MS_TAB); LAS unsigned* basev = hist + 64;
    for (int u = blockIdx.x; u < 1024; u += G) {
        const int jb = u & 63, bh = u >> 6, b = bh >> 3, h = bh & 7;
        if (tid < 64) hist[tid] = 0u;
        __syncthreads();
        if (jb > 0) {
            f32x4 acc[2][4];
#pragma unroll
            for (int qb = 0; qb < 2; ++qb)
#pragma unroll
                for (int nb = 0; nb < 4; ++nb) acc[qb][nb] = (f32x4){0.f, 0.f, 0.f, 0.f};
            const size_t qrow0 = (size_t)b * SEQ + 256 * jb + 32 * wave;
#pragma unroll
            for (int ks = 0; ks < 4; ++ks) {
                bf16x8 qf[2];
#pragma unroll
                for (int qb = 0; qb < 2; ++qb) qf[qb] = *(const bf16x8*)(Q + (qrow0 + 16 * qb + (lane & 15)) * 1024 + h * 128 + ks * 32 + 8 * (lane >> 4));
#pragma unroll
                for (int nb = 0; nb < 4; ++nb) { const float* kp = KM + ((size_t)(bh * 64 + 16 * nb + (lane & 15))) * 128 + ks * 32 + 8 * (lane >> 4);
                    const f32x4 k0 = *(const f32x4*)kp * (1.f / 256.f), k1 = *(const f32x4*)(kp + 4) * (1.f / 256.f); const u32x4 kw = pack8(k0, k1);
                    const bf16x8 kf = *(const bf16x8*)&kw;
#pragma unroll
                    for (int qb = 0; qb < 2; ++qb) acc[qb][nb] = __builtin_amdgcn_mfma_f32_16x16x32_bf16(kf, qf[qb], acc[qb][nb], 0, 0, 0); }
            }
#pragma unroll
            for (int qb = 0; qb < 2; ++qb)
#pragma unroll
                for (int nb = 0; nb < 4; ++nb)
#pragma unroll
                    for (int r = 0; r < 4; ++r) gl[(32 * wave + 16 * qb + (lane & 15)) * 65 + 16 * nb + 4 * (lane >> 4) + r] = acc[qb][nb][r];
        }
        __syncthreads();
        int sel0 = 0, sel1 = 0, sel2 = 0, sp0 = 0, sp1 = 0, sp2 = 0; const int nsel = jb < 3 ? jb : 3;
        if (tid < 256 && jb > 0) {
            const float NEG = -__builtin_inff(); float v0 = NEG, v1 = NEG, v2 = NEG; int i0 = 0, i1 = 1, i2 = 2;
            const LAS float* gp = gl + tid * 65;
#pragma unroll 1
            for (int n0 = 0; n0 < jb; n0 += 8) { float xs[8];
#pragma unroll
                for (int j = 0; j < 8; ++j) xs[j] = gp[n0 + j];
#pragma unroll
                for (int j = 0; j < 8; ++j) { const int n = n0 + j; const float x = n < jb ? xs[j] : NEG;
                    const bool g0 = x > v0, g1 = x > v1, g2 = x > v2;
                    v2 = g1 ? v1 : (g2 ? x : v2); i2 = g1 ? i1 : (g2 ? n : i2);
                    v1 = g0 ? v0 : (g1 ? x : v1); i1 = g0 ? i0 : (g1 ? n : i1);
                    v0 = g0 ? x : v0; i0 = g0 ? n : i0; } }
            sel0 = i0; sel1 = i1; sel2 = i2;
            if (nsel > 0) sp0 = (int)__hip_atomic_fetch_add((LAS unsigned*)&hist[sel0], 1u, __ATOMIC_RELAXED, __HIP_MEMORY_SCOPE_WORKGROUP);
            if (nsel > 1) sp1 = (int)__hip_atomic_fetch_add((LAS unsigned*)&hist[sel1], 1u, __ATOMIC_RELAXED, __HIP_MEMORY_SCOPE_WORKGROUP);
            if (nsel > 2) sp2 = (int)__hip_atomic_fetch_add((LAS unsigned*)&hist[sel2], 1u, __ATOMIC_RELAXED, __HIP_MEMORY_SCOPE_WORKGROUP);
        }
        __syncthreads();
        if (tid < 64) { const unsigned c = hist[tid]; basev[tid] = c ? __hip_atomic_fetch_add(acnt + bh * 64 + tid, c, __ATOMIC_RELAXED, __HIP_MEMORY_SCOPE_AGENT) : 0u; }
        __syncthreads();
        if (tid < 256 && jb > 0) { const int ql = 256 * jb + tid;
            if (nsel > 0) alist[(size_t)(bh * 64 + sel0) * 16384 + basev[sel0] + sp0] = (ql << 2) | 0;
            if (nsel > 1) alist[(size_t)(bh * 64 + sel1) * 16384 + basev[sel1] + sp1] = (ql << 2) | 1;
            if (nsel > 2) alist[(size_t)(bh * 64 + sel2) * 16384 + basev[sel2] + sp2] = (ql << 2) | 2; }
        __syncthreads();
    }
}

namespace at {
constexpr int KVBLK = 64, NW = 8, QBLK = 32;
constexpr int SHM_V = KVBLK * 128 * 2, SHM_K = KVBLK * 128 * 2;
constexpr int LDK = 1024;
constexpr float THR = 8.f, C = 1.4426950408889634f;
#define AT_KSWZ(row, colB) ((row) * 256 + ((colB) ^ (((row) & 7) << 4)))
#define AT_SBAR() __builtin_amdgcn_sched_barrier(0)
__device__ __forceinline__ int crow(int r, int hi) { return (r & 3) + 8 * (r >> 2) + 4 * hi; }
__device__ __forceinline__ void partialSM(f32x16& p0, f32x16& p1, float& m_reg, float& mn, float& alpha, int kbase, int qlim, int hi) {
#pragma unroll
    for (int r = 0; r < 16; ++r) { const int key = kbase + crow(r, hi); if (key > qlim) p0[r] = -1e30f; if (key + 32 > qlim) p1[r] = -1e30f; }
    float pmax = p0[0];
#pragma unroll
    for (int r = 1; r < 16; ++r) pmax = fmaxf(pmax, p0[r]);
#pragma unroll
    for (int r = 0; r < 16; ++r) pmax = fmaxf(pmax, p1[r]);
    { auto rr = __builtin_amdgcn_permlane32_swap(__float_as_uint(pmax), __float_as_uint(pmax), false, false);
      pmax = fmaxf(__uint_as_float(rr[0]), __uint_as_float(rr[1])); }
    if (__builtin_expect(__all(pmax - m_reg <= THR), 1)) { mn = m_reg; alpha = 1.f; }
    else { mn = fmaxf(m_reg, pmax); alpha = __builtin_amdgcn_exp2f((m_reg - mn) * C); m_reg = mn; }
    const float mnC = -mn * C;
#pragma unroll
    for (int r = 0; r < 16; ++r) p0[r] = fmaf(p0[r], C, mnC);
#pragma unroll
    for (int r = 0; r < 16; ++r) p1[r] = fmaf(p1[r], C, mnC);
#pragma unroll
    for (int r = 0; r < 16; ++r) p0[r] = __builtin_amdgcn_exp2f(p0[r]);
}
__device__ __forceinline__ void finishSM(f32x16& p0, f32x16& p1, float alpha, float& l_reg, bf16x8& pa0, bf16x8& pa1, bf16x8& pa2, bf16x8& pa3) {
#pragma unroll
    for (int r = 0; r < 16; ++r) p1[r] = __builtin_amdgcn_exp2f(p1[r]);
    float ps = 0;
#pragma unroll
    for (int r = 0; r < 16; ++r) ps += p0[r];
#pragma unroll
    for (int r = 0; r < 16; ++r) ps += p1[r];
    { auto rr = __builtin_amdgcn_permlane32_swap(__float_as_uint(ps), __float_as_uint(ps), false, false);
      ps = __uint_as_float(rr[0]) + __uint_as_float(rr[1]); }
    l_reg = l_reg * alpha + ps;
#define AT_PK4(P, BASE, OUT) do { unsigned a0 = cvt_pk_bf16(P[BASE + 0], P[BASE + 1]), a1 = cvt_pk_bf16(P[BASE + 2], P[BASE + 3]);   \
    unsigned b0 = cvt_pk_bf16(P[BASE + 4], P[BASE + 5]), b1 = cvt_pk_bf16(P[BASE + 6], P[BASE + 7]);                              \
    auto r0 = __builtin_amdgcn_permlane32_swap(a0, b0, false, false); auto r1 = __builtin_amdgcn_permlane32_swap(a1, b1, false, false); \
    u32x4 w = {r0[0], r1[0], r0[1], r1[1]}; OUT = *reinterpret_cast<bf16x8*>(&w); } while (0)
    AT_PK4(p0, 0, pa0); AT_PK4(p0, 8, pa1); AT_PK4(p1, 0, pa2); AT_PK4(p1, 8, pa3);
#undef AT_PK4
}
__device__ __forceinline__ void qkt(f32x16& p0, f32x16& p1, const LAS char* Ks, const bf16x8* qr, int r32, int hi) {
    p0 = f32x16{}; p1 = f32x16{};
#pragma unroll
    for (int d0 = 0; d0 < 8; ++d0) { const int cb = (d0 * 16 + hi * 8) * 2;
        const bf16x8 b0 = *(const LAS bf16x8*)(Ks + AT_KSWZ(r32, cb));
        const bf16x8 b1 = *(const LAS bf16x8*)(Ks + AT_KSWZ(32 + r32, cb));
        p0 = __builtin_amdgcn_mfma_f32_32x32x16_bf16(b0, qr[d0], p0, 0, 0, 0);
        p1 = __builtin_amdgcn_mfma_f32_32x32x16_bf16(b1, qr[d0], p1, 0, 0, 0); }
}
__device__ __forceinline__ int v_st(int k, int c) { const int kk = (k & ~0xC) | ((k & 4) << 1) | ((k & 8) >> 1); return ((kk >> 3) * 4 + (c >> 5)) * 512 + ((kk & 7) * 32 + (c & 31)) * 2; }
__device__ __forceinline__ int v_rd_base(int lane) { return ((lane & 3) << 3) | (((lane >> 2) & 3) << 6) | (((lane >> 4) & 1) << 5) | (((lane >> 5) & 1) << 8); }
constexpr int v_rd_off(int d0, int ks, int half) { return d0 * 512 + ks * 4096 + half * 2048; }
template <int OFF> __device__ __forceinline__ s16x4 tr_read(int vb) {
    s16x4 r; asm volatile("ds_read_b64_tr_b16 %0, %1 offset:%2" : "=&v"(r) : "v"(vb), "i"(OFF) : "memory"); return r;
}
template <int D0> __device__ __forceinline__ void pv_one(f32x16& od, int vb, bf16x8 pa0, bf16x8 pa1, bf16x8 pa2, bf16x8 pa3) {
    const s16x4 l0 = tr_read<v_rd_off(D0, 0, 0)>(vb), h0 = tr_read<v_rd_off(D0, 0, 1)>(vb), l1 = tr_read<v_rd_off(D0, 1, 0)>(vb), h1 = tr_read<v_rd_off(D0, 1, 1)>(vb);
    const s16x4 l2 = tr_read<v_rd_off(D0, 2, 0)>(vb), h2 = tr_read<v_rd_off(D0, 2, 1)>(vb), l3 = tr_read<v_rd_off(D0, 3, 0)>(vb), h3 = tr_read<v_rd_off(D0, 3, 1)>(vb);
    asm volatile("s_waitcnt lgkmcnt(0)" ::: "memory"); AT_SBAR();
#define AT_PK(L, H) (bf16x8){L[0], L[1], L[2], L[3], H[0], H[1], H[2], H[3]}
    od = __builtin_amdgcn_mfma_f32_32x32x16_bf16(pa0, AT_PK(l0, h0), od, 0, 0, 0);
    od = __builtin_amdgcn_mfma_f32_32x32x16_bf16(pa1, AT_PK(l1, h1), od, 0, 0, 0);
    od = __builtin_amdgcn_mfma_f32_32x32x16_bf16(pa2, AT_PK(l2, h2), od, 0, 0, 0);
    od = __builtin_amdgcn_mfma_f32_32x32x16_bf16(pa3, AT_PK(l3, h3), od, 0, 0, 0);
#undef AT_PK
}
__device__ __forceinline__ void pv_d0(f32x16* o, int vb, bf16x8 pa0, bf16x8 pa1, bf16x8 pa2, bf16x8 pa3) {
    pv_one<0>(o[0], vb, pa0, pa1, pa2, pa3); pv_one<1>(o[1], vb, pa0, pa1, pa2, pa3); pv_one<2>(o[2], vb, pa0, pa1, pa2, pa3); pv_one<3>(o[3], vb, pa0, pa1, pa2, pa3);
}
__device__ __forceinline__ void attn_unit(int tid, const bf16_t* Qw, const bf16_t* Kh, const bf16_t* Vh, int qlim, LAS char* lds, f32x16 (&o)[4], float& m_out, float& l_out) {
    asm volatile("" : "+v"(tid)); const int  wid = tid >> 6, lane = tid & 63, r32 = lane & 31, hi = lane >> 5;
    LAS char* V_lds = lds; LAS char* K_lds = lds + 2 * SHM_V;
    LAS float* wsf = (LAS float*)(lds + 2 * SHM_V + 2 * SHM_K) + wid * 64; LAS float* al_l = wsf + 32;
    float m_reg = -1e30f, l_reg = 0;
#pragma unroll
    for (int d = 0; d < 4; ++d) o[d] = f32x16{};
    bf16x8 qr[8];
#pragma unroll
    for (int d0 = 0; d0 < 8; ++d0) qr[d0] = *(const bf16x8*)(Qw + d0 * 16);
    const int sr = tid >> 4, sc = (tid & 15) * 8, vst0 = v_st(sr, sc), vst1 = v_st(32 + sr, sc);
    const int vb0 = (int)(uintptr_t)V_lds + v_rd_base(lane);
    bf16x8 vsE0, vsE1, ksE0, ksE1, vsO0, vsO1, ksO0, ksO1;
#define AT_SLOAD(S, k0) do { vs##S##0 = *(const bf16x8*)(Vh + (size_t)((k0) + sr) * LDK + sc); vs##S##1 = *(const bf16x8*)(Vh + (size_t)((k0) + 32 + sr) * LDK + sc); \
    ks##S##0 = *(const bf16x8*)(Kh + (size_t)((k0) + sr) * LDK + sc); ks##S##1 = *(const bf16x8*)(Kh + (size_t)((k0) + 32 + sr) * LDK + sc); } while (0)
#define AT_SWRITE(b, S) do { *(LAS bf16x8*)(V_lds + (b) * SHM_V + vst0) = vs##S##0; *(LAS bf16x8*)(V_lds + (b) * SHM_V + vst1) = vs##S##1; const int kc = sc * 2; \
    *(LAS bf16x8*)(K_lds + (b) * SHM_K + AT_KSWZ(sr, kc)) = ks##S##0; *(LAS bf16x8*)(K_lds + (b) * SHM_K + AT_KSWZ(32 + sr, kc)) = ks##S##1; } while (0)
#define AT_SWAIT() asm volatile("s_waitcnt vmcnt(4)" ::: "memory")
#define AT_RESC(a) do { if (__any((a) < 1.f)) { if (hi == 0) al_l[r32] = (a); asm volatile("s_waitcnt lgkmcnt(0)" ::: "memory"); \
    _Pragma("unroll") for (int d = 0; d < 4; ++d) _Pragma("unroll") for (int r = 0; r < 16; ++r) o[d][r] *= al_l[crow(r, hi)]; } } while (0)
    f32x16 pA0, pA1, pB0, pB1; float mnA, mnB, alA, alB; bf16x8 pa0, pa1, pa2, pa3;
    AT_SLOAD(E, 0); asm volatile("s_waitcnt vmcnt(0)" ::: "memory"); AT_SWRITE(0, E); __syncthreads();
    qkt(pA0, pA1, K_lds, qr, r32, hi); partialSM(pA0, pA1, m_reg, mnA, alA, 0, qlim, hi);
    AT_SLOAD(O, KVBLK); AT_SLOAD(E, 2 * KVBLK);
    AT_SWAIT(); AT_SWRITE(1, O); __syncthreads();
    {
        AT_SBAR(); qkt(pB0, pB1, K_lds + SHM_K, qr, r32, hi);
        finishSM(pA0, pA1, alA, l_reg, pa0, pa1, pa2, pa3); AT_SBAR();
        AT_SLOAD(O, 3 * KVBLK); AT_SBAR();
        pv_d0(o, vb0, pa0, pa1, pa2, pa3); partialSM(pB0, pB1, m_reg, mnB, alB, 64, qlim, hi);
        __syncthreads(); AT_SWAIT(); AT_SWRITE(0, E);
        AT_RESC(alB); __syncthreads();
        AT_SBAR(); qkt(pA0, pA1, K_lds, qr, r32, hi);
        finishSM(pB0, pB1, alB, l_reg, pa0, pa1, pa2, pa3); AT_SBAR();
        pv_d0(o, vb0 + SHM_V, pa0, pa1, pa2, pa3); partialSM(pA0, pA1, m_reg, mnA, alA, 128, qlim, hi);
        __syncthreads(); asm volatile("s_waitcnt vmcnt(0)" ::: "memory"); AT_SWRITE(1, O);
        AT_RESC(alA); __syncthreads();
    }
    AT_SBAR(); qkt(pB0, pB1, K_lds + SHM_K, qr, r32, hi);
    finishSM(pA0, pA1, alA, l_reg, pa0, pa1, pa2, pa3); AT_SBAR();
    pv_d0(o, vb0, pa0, pa1, pa2, pa3); partialSM(pB0, pB1, m_reg, mnB, alB, 192, qlim, hi);
    __syncthreads(); AT_RESC(alB);
    finishSM(pB0, pB1, alB, l_reg, pa0, pa1, pa2, pa3); AT_SBAR();
    pv_d0(o, vb0 + SHM_V, pa0, pa1, pa2, pa3);
    m_out = m_reg; l_out = l_reg;
#undef AT_SLOAD
#undef AT_SWRITE
#undef AT_SWAIT
#undef AT_RESC
}

__device__ __forceinline__ void stage_block(int tid, const bf16_t* Kh, const bf16_t* Vh, LAS char* lds) {
    asm volatile("" : "+v"(tid));
    const int sr = tid >> 4, sc = (tid & 15) * 8, vst0 = v_st(sr, sc), vst1 = v_st(32 + sr, sc), kc = sc * 2;
    LAS char* V_lds = lds; LAS char* K_lds = lds + 65536;
#pragma unroll
    for (int hf = 0; hf < 2; ++hf) {
        bf16x8 v0[2], v1[2], k0[2], k1[2];
#pragma unroll
        for (int jj = 0; jj < 2; ++jj) { const int kb = 64 * (2 * hf + jj);
            v0[jj] = __builtin_nontemporal_load((const bf16x8*)(Vh + (size_t)(kb + sr) * LDK + sc)); v1[jj] = __builtin_nontemporal_load((const bf16x8*)(Vh + (size_t)(kb + 32 + sr) * LDK + sc));
            k0[jj] = __builtin_nontemporal_load((const bf16x8*)(Kh + (size_t)(kb + sr) * LDK + sc)); k1[jj] = __builtin_nontemporal_load((const bf16x8*)(Kh + (size_t)(kb + 32 + sr) * LDK + sc)); }
#pragma unroll
        for (int jj = 0; jj < 2; ++jj) { const int jt = 2 * hf + jj;
            *(LAS bf16x8*)(V_lds + jt * SHM_V + vst0) = v0[jj]; *(LAS bf16x8*)(V_lds + jt * SHM_V + vst1) = v1[jj];
            *(LAS bf16x8*)(K_lds + jt * SHM_K + AT_KSWZ(sr, kc)) = k0[jj]; *(LAS bf16x8*)(K_lds + jt * SHM_K + AT_KSWZ(32 + sr, kc)) = k1[jj]; }
    }
}
__device__ __forceinline__ void attn_block_unit(int tid, const bf16x8 (&qr)[8], int qlim, int ntile_w, LAS char* lds, f32x16 (&o)[4], float& m_out, float& l_out) {
    asm volatile("" : "+v"(tid)); const int wid = tid >> 6, lane = tid & 63, r32 = lane & 31, hi = lane >> 5;
    LAS char* V_lds = lds; LAS char* K_lds = lds + 65536;
    LAS float* wsf = (LAS float*)(lds + 131072) + wid * 64; LAS float* al_l = wsf + 32;
    float m_reg = -1e30f, l_reg = 0;
#pragma unroll
    for (int d = 0; d < 4; ++d) o[d] = f32x16{};
    const int vb0 = (int)(uintptr_t)V_lds + v_rd_base(lane);
#pragma unroll
    for (int jt = 0; jt < 4; ++jt) {
        if (jt < ntile_w) {
            f32x16 p0, p1; float mn, al; bf16x8 pa0, pa1, pa2, pa3;
            qkt(p0, p1, K_lds + jt * SHM_K, qr, r32, hi);
            partialSM(p0, p1, m_reg, mn, al, 64 * jt, qlim, hi);
            if (__any(al < 1.f)) { if (hi == 0) al_l[r32] = al; asm volatile("s_waitcnt lgkmcnt(0)" ::: "memory");
#pragma unroll
                for (int d = 0; d < 4; ++d)
#pragma unroll
                    for (int r = 0; r < 16; ++r) o[d][r] *= al_l[crow(r, hi)]; }
            finishSM(p0, p1, al, l_reg, pa0, pa1, pa2, pa3); AT_SBAR();
            pv_d0(o, vb0 + jt * SHM_V, pa0, pa1, pa2, pa3);
        }
    }
    m_out = m_reg; l_out = l_reg;
}
}

__device__ __forceinline__ void phase_attn(int tid, const bf16_t* Q, const bf16_t* KB, const bf16_t* VB, unsigned* acnt, const int* alist, bf16_t* PART, float* ML, LAS unsigned char* lds, int G, int vcu) {
    asm volatile("" : "+v"(tid)); const int  wave = __builtin_amdgcn_readfirstlane(tid >> 6), lane = tid & 63, r32 = lane & 31, hi = lane >> 5;
    LAS int* ustart = (LAS int*)(lds + MISC_OFF + MS_TAB);
    LAS int* qtab = ustart + 1028;
    LAS int* dtab = qtab + 256;
    LAS int* wtot = dtab + 256;
    __syncthreads();
    {
        const int c0 = (int)__hip_atomic_load(acnt + 2 * tid, __ATOMIC_RELAXED, __HIP_MEMORY_SCOPE_AGENT), c1 = (int)__hip_atomic_load(acnt + 2 * tid + 1, __ATOMIC_RELAXED, __HIP_MEMORY_SCOPE_AGENT);
        const int t0 = 1 + ((c0 + 255) >> 8), t1 = 1 + ((c1 + 255) >> 8);
        LAS int* ps = qtab;
        ps[tid] = t0 + t1;
        __syncthreads();
        int pre = 0;
        for (int j = 0; j < lane; ++j) pre += ps[wave * 64 + j];
        if (lane == 63) wtot[wave] = pre + t0 + t1;
        __syncthreads();
        for (int w = 0; w < wave; ++w) pre += wtot[w];
        __syncthreads();
        ustart[2 * tid] = pre; ustart[2 * tid + 1] = pre + t0;
        if (tid == 511) ustart[1024] = pre + t0 + t1;
        __syncthreads();
    }
    const int total = ustart[1024];
    for (int u = vcu; u < total; u += G) {
        int lo = 0, hiu = 1024;
#pragma unroll 1
        while (hiu - lo > 1) { const int mid = (lo + hiu) >> 1; if (ustart[mid] <= u) lo = mid; else hiu = mid; }
        const int li = lo, t = u - ustart[li], n = li & 63, bh = li >> 6, b = bh >> 3, h = bh & 7;
        const int cnt = (int)__hip_atomic_load(acnt + li, __ATOMIC_RELAXED, __HIP_MEMORY_SCOPE_AGENT);
        if (tid < 256) {
            int qrow, dst;
            if (t == 0) { qrow = b * SEQ + 256 * n + tid; dst = (qrow * 8 + h) * 4 + 3; }
            else { const int idx = 256 * (t - 1) + tid;
                if (idx < cnt) { const int e = alist[(size_t)li * 16384 + idx]; qrow = b * SEQ + (e >> 2); dst = (qrow * 8 + h) * 4 + (e & 3); }
                else { qrow = b * SEQ; dst = -1; } }
            qtab[tid] = qrow; dtab[tid] = dst;
        }
        __syncthreads();
        const int R = wave * 32 + r32; const int qrow = qtab[R];
        const int qlim = (t == 0) ? R : (1 << 30);
        f32x16 o[4]; float m_r, l_r;
        at::attn_unit(tid, Q + (size_t)qrow * 1024 + h * 128 + hi * 8, KB + ((size_t)b * SEQ + 256 * n) * 1024 + h * 128, VB + ((size_t)b * SEQ + 256 * n) * 1024 + h * 128, qlim,
                      (LAS char*)lds, o, m_r, l_r);
        if (hi == 0) { const int d = dtab[R]; if (d >= 0) *(f32x2*)(ML + (size_t)d * 2) = (f32x2){m_r, l_r}; }
#pragma unroll
        for (int r = 0; r < 16; ++r) { const int d = dtab[wave * 32 + at::crow(r, hi)];
            if (d >= 0) {
#pragma unroll
                for (int d0 = 0; d0 < 4; ++d0) PART[(size_t)d * 128 + d0 * 32 + r32] = (bf16_t)(cvt_pk_bf16(o[d0][r], 0.f) & 0xffffu); } }
        __syncthreads();
    }
}
__device__ __forceinline__ void phase_attn2(int tid, const bf16_t* Q, const bf16_t* KB, const bf16_t* VB, unsigned* acnt, const int* alist, bf16_t* PART, float* ML, unsigned* qhead, LAS unsigned char* lds) {
    asm volatile("" : "+v"(tid)); const int wave = __builtin_amdgcn_readfirstlane(tid >> 6), lane = tid & 63, r32 = lane & 31, hi = lane >> 5;
    LAS int* qtab = (LAS int*)(lds + MISC_OFF + MS_TAB);
    LAS int* dtab = qtab + 256;
    LAS int* bc = dtab + 256;
    LAS int* cnts = (LAS int*)(lds + 133120);
    cnts[2 * tid] = (int)__hip_atomic_load(acnt + 2 * tid, __ATOMIC_RELAXED, __HIP_MEMORY_SCOPE_AGENT); cnts[2 * tid + 1] = (int)__hip_atomic_load(acnt + 2 * tid + 1, __ATOMIC_RELAXED, __HIP_MEMORY_SCOPE_AGENT);
    unsigned nidx = 0u;
    if (tid == 0) nidx = __hip_atomic_fetch_add(qhead, 1u, __ATOMIC_RELAXED, __HIP_MEMORY_SCOPE_AGENT);
    for (;;) {
        __syncthreads();
        if (tid == 0) { const unsigned idx = nidx; int c = 0;
            if (idx < 1024u) { c = cnts[(idx & 15u) * 64u + (idx >> 4)]; nidx = __hip_atomic_fetch_add(qhead, 1u, __ATOMIC_RELAXED, __HIP_MEMORY_SCOPE_AGENT); }
            bc[0] = (int)idx; bc[1] = c; }
        __syncthreads();
        const int idx = bc[0]; if (idx >= 1024) break;
        const int cnt = bc[1], n = idx >> 4, bh = idx & 15, b = bh >> 3, h = bh & 7, li = bh * 64 + n;
        const int T = 1 + ((cnt + 255) >> 8);
        at::stage_block(tid, KB + ((size_t)b * SEQ + 256 * n) * 1024 + h * 128, VB + ((size_t)b * SEQ + 256 * n) * 1024 + h * 128, (LAS char*)lds);
        const int R = wave * 32 + r32;
        LAS int* dloc = dtab + wave * 32;
        const bf16_t* Qh = Q + h * 128 + hi * 8;
        int ecur = 0, enx = 0;
        if (T > 1) enx = alist[(size_t)li * 16384 + (R < cnt ? R : 0)];
        bf16x8 qr[8];
        {   const bf16_t* Qw = Qh + (size_t)(b * SEQ + 256 * n + R) * 1024;
#pragma unroll
            for (int d0 = 0; d0 < 8; ++d0) qr[d0] = *(const bf16x8*)(Qw + d0 * 16); }
        __syncthreads();
#pragma unroll 1
        for (int t = 0; t < T; ++t) {
            int qrow, dst;
            if (t == 0) { qrow = b * SEQ + 256 * n + R; dst = (qrow * 8 + h) * 4 + 3; }
            else { const bool ok = 256 * (t - 1) + R < cnt; qrow = b * SEQ + (ok ? (ecur >> 2) : 0); dst = ok ? ((qrow * 8 + h) * 4 + (ecur & 3)) : -1; }
            bf16x8 qn[8]; int enx2 = 0;
            if (t + 1 < T) { const bool ok1 = 256 * t + R < cnt; const bf16_t* Qw = Qh + (size_t)(b * SEQ + (ok1 ? (enx >> 2) : 0)) * 1024;
#pragma unroll
                for (int d0 = 0; d0 < 8; ++d0) qn[d0] = *(const bf16x8*)(Qw + d0 * 16);
            } else {
#pragma unroll
                for (int d0 = 0; d0 < 8; ++d0) qn[d0] = qr[d0]; }
            if (t + 2 < T) { const int i2 = 256 * (t + 1) + R; enx2 = alist[(size_t)li * 16384 + (i2 < cnt ? i2 : 0)]; }
            if (hi == 0) dloc[r32] = dst;
            const int qlim = (t == 0) ? R : (1 << 30); const int ntw = (t == 0) ? (((wave * 32 + 31) >> 6) + 1) : 4;
            f32x16 o[4]; float m_r, l_r;
            at::attn_block_unit(tid, qr, qlim, ntw, (LAS char*)lds, o, m_r, l_r);
#pragma unroll
            for (int d0 = 0; d0 < 8; ++d0) qr[d0] = qn[d0];
            ecur = enx; enx = enx2;
            if (hi == 0 && dst >= 0) *(f32x2*)(ML + (size_t)dst * 2) = (f32x2){m_r, l_r};
            asm volatile("s_waitcnt lgkmcnt(0)" ::: "memory");
#pragma unroll
            for (int r = 0; r < 16; ++r) { const int d = dloc[at::crow(r, hi)];
                if (d >= 0) {
#pragma unroll
                    for (int d0 = 0; d0 < 4; ++d0) PART[(size_t)d * 128 + d0 * 32 + r32] = (bf16_t)(cvt_pk_bf16(o[d0][r], 0.f) & 0xffffu); } }
            asm volatile("s_waitcnt lgkmcnt(0)" ::: "memory");
        }
    }
}
__device__ __forceinline__ void phase_attn_combine(const bf16_t* PART, const float* ML, bf16_t* ATT, int gw, int NGW, int lane) {
    for (int t = gw; t < NTOK; t += NGW) {
        const int own = (t & (SEQ - 1)) >> 8, nsel = own < 3 ? own : 3, head = lane >> 3, c16 = (lane & 7) * 16;
        const size_t p4 = ((size_t)t * 8 + head) * 4;
        f32x2 ml[4]; u32x4 pa[4], pb[4];
#pragma unroll
        for (int s = 0; s < 4; ++s) { ml[s] = *(const f32x2*)(ML + (p4 + s) * 2); pa[s] = __builtin_nontemporal_load((const u32x4*)(PART + (p4 + s) * 128 + c16)); pb[s] = __builtin_nontemporal_load((const u32x4*)(PART + (p4 + s) * 128 + c16 + 8)); }
        float ms[4], ls[4]; float M = -1e30f;
#pragma unroll
        for (int s = 0; s < 4; ++s) { const bool valid = (s == 3) || (s < nsel); ms[s] = valid ? ml[s].x : -1e30f; ls[s] = valid ? ml[s].y : 0.f; M = fmaxf(M, ms[s]); }
        float acc[16];
#pragma unroll
        for (int j = 0; j < 16; ++j) acc[j] = 0.f;
        float L = 0.f;
#pragma unroll
        for (int s = 0; s < 4; ++s) { const bool valid = (s == 3) || (s < nsel);
            const float w = valid ? __builtin_amdgcn_exp2f((ms[s] - M) * 1.4426950408889634f) : 0.f; L += w * ls[s];
            const u32x4 a = valid ? pa[s] : (u32x4){0u, 0u, 0u, 0u}, bq = valid ? pb[s] : (u32x4){0u, 0u, 0u, 0u};
            acc[0] += w * bflo(a.x); acc[1] += w * bfhi(a.x); acc[2] += w * bflo(a.y); acc[3] += w * bfhi(a.y); acc[4] += w * bflo(a.z); acc[5] += w * bfhi(a.z); acc[6] += w * bflo(a.w); acc[7] += w * bfhi(a.w);
            acc[8] += w * bflo(bq.x); acc[9] += w * bfhi(bq.x); acc[10] += w * bflo(bq.y); acc[11] += w * bfhi(bq.y); acc[12] += w * bflo(bq.z); acc[13] += w * bfhi(bq.z); acc[14] += w * bflo(bq.w); acc[15] += w * bfhi(bq.w); }
        const float inv = 1.0f / L;
        u32x4 o0, o1;
        o0.x = cvt_pk_bf16(acc[0] * inv, acc[1] * inv); o0.y = cvt_pk_bf16(acc[2] * inv, acc[3] * inv); o0.z = cvt_pk_bf16(acc[4] * inv, acc[5] * inv); o0.w = cvt_pk_bf16(acc[6] * inv, acc[7] * inv);
        o1.x = cvt_pk_bf16(acc[8] * inv, acc[9] * inv); o1.y = cvt_pk_bf16(acc[10] * inv, acc[11] * inv); o1.z = cvt_pk_bf16(acc[12] * inv, acc[13] * inv); o1.w = cvt_pk_bf16(acc[14] * inv, acc[15] * inv);
        *(u32x4*)(ATT + (size_t)t * 1024 + head * 128 + c16) = o0; *(u32x4*)(ATT + (size_t)t * 1024 + head * 128 + c16 + 8) = o1;
    }
}

struct Args { const float* in[29]; float* out; unsigned char* ws; int ph_lo, ph_hi; float inv_freq[16]; };

__global__ void __launch_bounds__(NTHR, 2) mk_fwd(Args a) {
    extern __shared__ __attribute__((aligned(16))) unsigned char lds_raw[];
    LAS unsigned char* lds = (LAS unsigned char*)lds_raw;
    const int G = gridDim.x, NGW = G * NWAVES;
    const size_t gthreads = (size_t)G * NTHR;
    const int vcu = (G % 8 == 0) ? (int)(blockIdx.x % 8) * (G / 8) + (int)(blockIdx.x / 8) : (int)blockIdx.x;
    const int wave0 = __builtin_amdgcn_readfirstlane(threadIdx.x >> 6);
    if (threadIdx.x < 16) ((LAS unsigned*)(lds + MISC_OFF))[threadIdx.x] = 0u;
    __syncthreads();
    typedef const Args __attribute__((address_space(4))) * ArgsP;
    const ArgsP ap0 = (ArgsP)__builtin_amdgcn_kernarg_segment_ptr();
#define ctl ((unsigned*)(ws + WS_CTL))
#define KM ((float*)(ws + WS_KM))
#define ROPE ((float*)(ws + WS_ROPE))
#define wl (ws + WS_WL + (size_t)(l & 1) * (WS_WL2 - WS_WL))
#define w_mix0 ((bf16_t*)(wl + WL_MIX))
#define gates_t ((bf16_t*)(wl + WL_MIX + 4 * MiB))
#define w_out_t ((bf16_t*)(wl + WL_MIX + 5 * MiB))
#define wq_t ((bf16_t*)(wl + WL_MIX))
#define wo_t ((bf16_t*)(wl + WL_MIX + 2 * MiB))
#define wkv_t ((bf16_t*)(wl + WL_MIX + 4 * MiB))
#define router_t ((bf16_t*)(wl + WL_ROUTER))
#define shgu_t ((bf16_t*)(wl + WL_SHGU))
#define shd_t ((bf16_t*)(wl + WL_SHD))
#define pleg_t ((bf16_t*)(wl + WL_PLEG))
#define plew_t ((bf16_t*)(wl + WL_PLEW))
#define egu_t ((bf16_t*)(wl + WL_EGU))
#define ed_t ((bf16_t*)(wl + WL_ED))
#define PB ((bf16_t*)(ws + WS_PB))
#define SB0 ((bf16_t*)(ws + WS_SB0))
#define SB1 ((bf16_t*)(ws + WS_SB1))
#define KBUF ((bf16_t*)(ws + WS_KB))
#define VBUF ((bf16_t*)(ws + WS_VB))
#define PW ((bf16_t*)(ws + WS_PW))
#define HDN ((bf16_t*)(ws + WS_HDN))
#define HSH ((bf16_t*)(ws + WS_HSH))
#define YSH ((unsigned char*)(ws + WS_YSH))
#define YP ((unsigned char*)(ws + WS_YP))
#define ELIST ((int*)(ws + WS_ELIST))
#define WPAIR ((float*)(ws + WS_WPAIR))
#define PPOS ((int*)(ws + WS_PPOS))
#define IDL ((int*)(ws + WS_IDL))
#define XBR ((bf16_t*)(ws + WS_XBR))
#define YG ((bf16_t*)(ws + WS_Y))
#define XC ((bf16_t*)(ws + WS_XC))
#define LAb ((bf16_t*)(ws + WS_LA))
#define Ub ((bf16_t*)(ws + WS_U))
#define HY ((bf16_t*)(ws + WS_HY))
#define CH ((float*)(ws + WS_CH))
#define CL (CH + 512 * 1024)
#define CIN (CH + 2 * 512 * 1024)
#define SP8 (CH + 3 * 512 * 1024)
#define QB ((bf16_t*)(ws + WS_Q))
#define ATT ((bf16_t*)(ws + WS_ATT))
#define PART ((bf16_t*)(ws + WS_PART))
#define ML ((float*)(ws + WS_ML))
#define ALIST ((int*)(ws + WS_ALIST))
#define in_x (IN(0))
#define IN(k) ((const float*)ap->in[k])
#define ln_g (IN(2) + (size_t)l * 2 * DM)
#define ln_b (IN(3) + (size_t)l * 2 * DM)

#if MK_MULTI
#define GRID_BAR() do { } while (0)
#else
    XcdBarrier bar; { unsigned char* ws = a.ws; bar = xcd_barrier_post(ctl + CW_BAR, (volatile LAS unsigned*)(lds + MISC_OFF + MS_BAR)); }
#define GRID_BAR() xcd_barrier(bar, wave0 == 0 && lane_id() == 0)
#endif
    int pid = 0;
#ifndef PH_MASK
#define PH_MASK 0xFFFFFFFFu
#endif
#ifndef DUP_MASK
#define DUP_MASK 0u
#endif
#define PHASE_BEGIN(k) if (((PH_MASK >> (k)) & 1u) && a.ph_lo <= pid && pid < a.ph_hi) { for (int rep_ = 0; rep_ < 1 + (int)((DUP_MASK >> (k)) & 1u); ++rep_) { ArgsP ap = ap0; asm volatile("" : "+s"(ap)); unsigned char* ws = ap->ws; int tid = wave0 * 64 + lane_id(); asm volatile("" : "+v"(tid)); const int lane = tid & 63, wave = wave0, gw = blockIdx.x * NWAVES + wave; const size_t gtid = (size_t)blockIdx.x * NTHR + tid; (void)lane; (void)gw; (void)gtid;
#define PHASE_END GRID_BAR(); } } ++pid;

#define wlL(LL) (ws + WS_WL + (size_t)((LL) & 1) * (WS_WL2 - WS_WL))
#define w_mix0_L ((bf16_t*)(wlL(LL) + WL_MIX))
#define gates_t_L ((bf16_t*)(wlL(LL) + WL_MIX + 4 * MiB))
#define w_out_t_L ((bf16_t*)(wlL(LL) + WL_MIX + 5 * MiB))
#define wq_t_L ((bf16_t*)(wlL(LL) + WL_MIX))
#define wo_t_L ((bf16_t*)(wlL(LL) + WL_MIX + 2 * MiB))
#define wkv_t_L ((bf16_t*)(wlL(LL) + WL_MIX + 4 * MiB))
#define router_t_L ((bf16_t*)(wlL(LL) + WL_ROUTER))
#define shgu_t_L ((bf16_t*)(wlL(LL) + WL_SHGU))
#define shd_t_L ((bf16_t*)(wlL(LL) + WL_SHD))
#define pleg_t_L ((bf16_t*)(wlL(LL) + WL_PLEG))
#define plew_t_L ((bf16_t*)(wlL(LL) + WL_PLEW))
#define egu_t_L ((bf16_t*)(wlL(LL) + WL_EGU))
#define ed_t_L ((bf16_t*)(wlL(LL) + WL_ED))
#define LP_BODY(LL) do { \
            LAS float* scr = (LAS float*)(lds + wave * 16384); \
            int base = 0; \
            if (LL < 2) { \
                conv_job(IN(4) + (size_t)LL * 1024 * 2048, w_mix0_L, 1024, 2048, 1, 0, 0, base, gw, NGW, scr, lane); \
                conv_job(IN(8) + (size_t)LL * 4 * 65536, gates_t_L, 256, 256, 4, 512 * 256, 1, base, gw, NGW, scr, lane); \
                conv_job(IN(10) + (size_t)LL * 4 * 65536, gates_t_L, 256, 256, 4, 512 * 256, 2, base, gw, NGW, scr, lane); \
                conv_job(IN(13) + (size_t)LL * 1024 * 1024, w_out_t_L, 1024, 1024, 1, 0, 0, base, gw, NGW, scr, lane); \
            } else { \
                conv_job(IN(17) + (size_t)(LL - 2) * 1024 * 1024, wq_t_L, 1024, 1024, 1, 0, 0, base, gw, NGW, scr, lane); \
                conv_job(IN(18) + (size_t)(LL - 2) * 1024 * 1024, wo_t_L, 1024, 1024, 1, 0, 0, base, gw, NGW, scr, lane); \
                if (LL == 2) conv_job(IN(16), wkv_t_L, 1024, 2048, 1, 0, 0, base, gw, NGW, scr, lane); \
            } \
            conv_job(IN(19) + (size_t)LL * 1024 * 64, router_t_L, 1024, 64, 1, 0, 0, base, gw, NGW, scr, lane); \
            conv_job(IN(24) + (size_t)LL * 1024 * 256, shgu_t_L, 1024, 256, 1, 0, 1, base, gw, NGW, scr, lane); \
            conv_job(IN(25) + (size_t)LL * 1024 * 256, shgu_t_L, 1024, 256, 1, 0, 2, base, gw, NGW, scr, lane); \
            conv_job(IN(26) + (size_t)LL * 256 * 1024, shd_t_L, 256, 1024, 1, 0, 0, base, gw, NGW, scr, lane); \
            conv_job(IN(28) + (size_t)LL * 1024 * 1024, pleg_t_L, 1024, 1024, 1, 0, 0, base, gw, NGW, scr, lane); \
            conv_job(IN(27) + (size_t)LL * 256 * 1024, plew_t_L, 256, 1024, 1, 0, 0, base, gw, NGW, scr, lane); \
            conv_job(IN(21) + (size_t)LL * 64 * 1024 * 256, egu_t_L, 1024, 256, 64, 512 * 1024, 1, base, gw, NGW, scr, lane); \
            conv_job(IN(22) + (size_t)LL * 64 * 1024 * 256, egu_t_L, 1024, 256, 64, 512 * 1024, 2, base, gw, NGW, scr, lane); \
            conv_job(IN(23) + (size_t)LL * 64 * 256 * 1024, ed_t_L, 256, 1024, 64, 1024 * 256, 0, base, gw, NGW, scr, lane); \
            cvt_f32_bf16(IN(1) + (size_t)LL * NTOK * PLE, PB, (size_t)NTOK * PLE / 8, gtid, gthreads); \
            if (LL == 0) { for (size_t i = gtid; i < (size_t)NTOK; i += gthreads) IDL[i] = (int)i * 8; } \
            if (LL < 2) { for (size_t i = gtid; i < 1024; i += gthreads) SP8[i] = -8.0f * log1pf(__expf(-IN(12)[(size_t)LL * 1024 + i])); } \
            if (LL == 0) { \
                cvt_f32_bf16(in_x, SB0, (size_t)NTOK * DM / 8, gtid, gthreads); \
                for (size_t i = gtid; i < (size_t)SEQ * 16; i += gthreads) { const int pos = (int)(i >> 4), fi = (int)(i & 15); \
                    const float ang = (float)pos * ap->inv_freq[fi]; const double rev = (double)ang * 0.15915494309189533577; const float fr_ = (float)(rev - floor(rev)); \
                    ROPE[i] = __builtin_amdgcn_cosf(fr_); ROPE[(size_t)SEQ * 16 + i] = __builtin_amdgcn_sinf(fr_); } \
            } \
        } while (0)
    { const int l = 0; (void)l;
        PHASE_BEGIN(0)
            { const int LL = 0; LP_BODY(LL); }
            __syncthreads();
        PHASE_END
    }
#pragma unroll 1
    for (int l = 0; l < DEPTH; ++l) {
        bool mixer_on = true;
        if (l < 2) {
#if EN_RGLRU
            PHASE_BEGIN(1)
                SchedStatic S{128, 8, G, (int)blockIdx.x, w_mix0, 1024, 0, 0}; EpiWin E{XBR, YG, IN(5) + (size_t)l * 2048};
                ge::gemm_phase<1024, 1024, 1024, 0, 3, false, false, true>(lds, tid, SB0, S, E);
            PHASE_END
            PHASE_BEGIN(2)
                phase_conv(XBR, XC, IN(6) + (size_t)l * 4 * 1024, IN(7) + (size_t)l * 1024, gw, NGW, lane);
            PHASE_END
            PHASE_BEGIN(3)
                SchedStatic S{128, 8, G, (int)blockIdx.x, gates_t, 256, 2, 512}; EpiGates E{XC, (unsigned char*)LAb, Ub, IN(9) + (size_t)l * 1024, IN(11) + (size_t)l * 1024, SP8};
                ge::gemm_phase<256, 1024, 256, 0, 1, false>(lds, tid, XC, S, E);
            PHASE_END
            PHASE_BEGIN(4)
                phase_scan1((const unsigned char*)LAb, Ub, SP8, CH, CL, gw, NGW, lane);
            PHASE_END
            PHASE_BEGIN(5)
                phase_scan_carry(CH, CL, CIN, tid, lds, G);
            PHASE_END
            PHASE_BEGIN(6)
                phase_scan2((const unsigned char*)LAb, Ub, YG, SP8, CIN, HY, gw, NGW, lane);
            PHASE_END
#else
            mixer_on = false;
#endif
        } else {
#if EN_MOBA
            if (l == 2) {
                PHASE_BEGIN(7)
                    phase_ln_rows(SB0, IN(14), IN(15), ATT, gw, NGW, lane);
                PHASE_END
            }
            PHASE_BEGIN(9)
                if (l == 2) { SchedStatic S{128, 8, G, (int)blockIdx.x, wkv_t, 1024, 0, 0}; EpiKV E{KBUF, VBUF, ROPE, KM};
                    ge::gemm_phase<1024, 1024, 1024, 0, 4, false, false, true>(lds, tid, ATT, S, E); }
                { SchedStatic S{128, 4, G, (int)blockIdx.x, wq_t, 1024, 0, 0}; EpiQ E{QB, ROPE};
                  ge::gemm_phase<1024, 1024, 1024, 0, 4, false, false, true>(lds, tid, SB0, S, E); }
            PHASE_END
            PHASE_BEGIN(10)
                phase_gate(tid, QB, KM, ctl + CW_ACNT + (l - 2) * 1024, ALIST, lds, G);
            PHASE_END
            PHASE_BEGIN(11)
                phase_attn2(tid, QB, KBUF, VBUF, ctl + CW_ACNT + (l - 2) * 1024, ALIST, PART, ML, ctl + CW_AQ + (l - 2) * 64, lds);
            PHASE_END
            PHASE_BEGIN(12)
                phase_attn_combine(PART, ML, ATT, gw, NGW, lane);
            PHASE_END
#else
            mixer_on = false;
#endif
        }
        PHASE_BEGIN(13)
            if (mixer_on) {
                SchedStatic S{128, 4, G, (int)blockIdx.x, (l < 2) ? w_out_t : wo_t, 1024, 0, 0}; EpiZ E{SB0, SB1};
                ge::gemm_phase<1024, 1024, 1024, 0, 3, false, false, true>(lds, tid, (l < 2) ? HY : ATT, S, E);
            } else {
                for (size_t i = gtid; i < (size_t)NTOK * DM / 4; i += gthreads) { const u32x2 xw = *(const u32x2*)(SB0 + i * 4); *(u32x2*)(SB1 + i * 4) = pack4((f32x4){bflo(xw.x), bfhi(xw.x), bflo(xw.y), bfhi(xw.y)} * DN_ALPHA); }
            }
        PHASE_END
        PHASE_BEGIN(14)
            phase_r1(tid, ln_g, ln_b, SB1, router_t, IN(20) + (size_t)l * 64, ctl + CW_ECNT + l * 128, ELIST, WPAIR, PPOS, lds, G);
        PHASE_END
        PHASE_BEGIN(15)
            { MoeTab T = moe_tables<true>(tid, ctl + CW_ECNT + l * 128, lds);
              SchedMoe1 S{T, G, vcu, ELIST, egu_t, shgu_t, IDL}; EpiMoe1 E{HDN, HSH};
              ge::gemm_phase<1024, 1024, 1024, 3, 1, true, false, true>(lds, tid, SB1, S, E); }
            {
              const int U = (((LAS int*)(lds + MISC_OFF + MS_TAB))[64] + 128) * 2, rem = U % G;
              const int Gp = rem ? G - rem : G, cp = rem ? vcu - rem : vcu;
              if (cp >= 0) { SchedStatic S{128, 4, Gp, cp, plew_t, 256, 0, 0}; EpiBf16 E{PW, 1024};
                ge::gemm_phase<256, 256, 256, 0, 3, false>(lds, tid, PB, S, E); } }
        PHASE_END
        PHASE_BEGIN(16)
            MoeTab T = moe_tables_view(lds);
            SchedMoe2 S{T, G, vcu, ELIST, ed_t, shd_t}; EpiMoe2 E{YP, YSH};
            ge::gemm_phase<256, 256, 256, 0, 2, false, true>(lds, tid, HDN, S, E);
        PHASE_END
        PHASE_BEGIN(17)
            MoeTab T = moe_tables_view(lds);
            phase_m4(ln_g + DM, ln_b + DM, SB1, YP, YSH, WPAIR, PPOS, T.sbase, gw, NGW, lane);
        PHASE_END
        PHASE_BEGIN(18)
            const int par = (int)(blockIdx.x & 1);
#pragma unroll 1
            for (int st = 0; st < 2; ++st) {
                if ((st ^ par) != 0) {
                    SchedStatic S{128, 4, G, (int)blockIdx.x, pleg_t, 1024, 0, 0}; EpiPle E{SB1, PW, (l == DEPTH - 1) ? (float*)ap->out : nullptr, SB0};
                    ge::gemm_phase<1024, 1024, 1024, 0, 3, false, false, true>(lds, tid, SB1, S, E);
                } else if (l + 1 < DEPTH) {
                    ArgsP ap = ap0; asm volatile("" : "+s"(ap)); unsigned char* ws = ap->ws; int tid = wave0 * 64 + lane_id(); asm volatile("" : "+v"(tid));
                    const int lane = tid & 63, wave = wave0, gw = blockIdx.x * NWAVES + wave; const size_t gtid = (size_t)blockIdx.x * NTHR + tid;
                    const int LL = l + 1; LP_BODY(LL); __syncthreads(); }
            }
#if MK_MULTI
        PHASE_END
#else
        if (l + 1 < DEPTH) GRID_BAR(); } } ++pid;
#endif
    }
}

static int count_phases() {
    int n = 1;
    for (int l = 0; l < DEPTH; ++l) { if (l < 2) n += EN_RGLRU ? 6 : 0; else n += EN_MOBA ? ((l == 2 ? 1 : 0) + 4) : 0; n += 1 + 1 + 1 + 2 + 1; }
    return n;
}
extern "C" void kernel_launch(void* const* d_in, const int* in_sizes, int n_in, void* d_out, int out_size, void* d_ws, size_t ws_size, hipStream_t stream) {
    static int grid = 0;
    if (grid == 0) {
        if (n_in != 29 || out_size != NTOK * DM || ws_size < WS_END) { fprintf(stderr, "kernel_launch: unexpected shapes (n_in %d out %d ws %zu need %zu)\n", n_in, out_size, ws_size, (size_t)WS_END); grid = -1; return; }
        int dev = 0, cus = 0, per_cu = 0;
        if (hipGetDevice(&dev) != hipSuccess || hipDeviceGetAttribute(&cus, hipDeviceAttributeMultiprocessorCount, dev) != hipSuccess) { grid = -1; return; }
        if (hipFuncSetAttribute((const void*)mk_fwd, hipFuncAttributeMaxDynamicSharedMemorySize, LDS_BYTES) != hipSuccess) { fprintf(stderr, "kernel_launch: hipFuncSetAttribute failed\n"); grid = -1; return; }
        if (hipOccupancyMaxActiveBlocksPerMultiprocessor(&per_cu, (const void*)mk_fwd, NTHR, LDS_BYTES) != hipSuccess || per_cu < 1) { fprintf(stderr, "kernel_launch: occupancy query says %d\n", per_cu); (void)hipGetLastError(); grid = -1; return; }
        grid = cus;
    }
    if (grid < 0) return;
    (void)hipMemsetAsync((char*)d_ws + WS_CTL, 0, CTL_BYTES, stream);
    Args a{};
    for (int i = 0; i < 29; ++i) a.in[i] = (const float*)d_in[i];
    a.out = (float*)d_out; a.ws = (unsigned char*)d_ws;
    for (int i = 0; i < 16; ++i) a.inv_freq[i] = (float)pow(500000.0, -(double)(2 * i) / 32.0);
#if MK_MULTI
    const int np = count_phases();
    for (int p = 0; p < np; ++p) { a.ph_lo = p; a.ph_hi = p + 1; hipLaunchKernelGGL(mk_fwd, dim3(grid), dim3(NTHR), LDS_BYTES, stream, a); }
#else
    a.ph_lo = 0; a.ph_hi = 1 << 30;
    hipLaunchKernelGGL(mk_fwd, dim3(grid), dim3(NTHR), LDS_BYTES, stream, a);
#endif
    const hipError_t le = hipPeekAtLastError();
    if (le != hipSuccess) fprintf(stderr, "kernel_launch: launch failed: %s\n", hipGetErrorName(le));
}
```
